# Optimizing an MI355X kernel written in HIP

```python
import math
import jax, jax.numpy as jnp
from jax import lax
import numpy as np

D_MODEL = 2048
BATCH = 4
SEQ = 2048
DEPTH = 2

D_MIX = D_MODEL
GLA_W = D_MIX // 4
GDN_W = D_MIX // 4
DIFF_W = D_MIX // 2
GLA_HEADS = 4
GLA_DV = GLA_W // GLA_HEADS
GLA_DK = GLA_DV // 2
GLA_RANK = 16
GLA_TAU = 16.0
GDN_HEADS = 4
GDN_D = GDN_W // GDN_HEADS
CONV_K = 4
DIFF_HEADS = 4
DIFF_DV = DIFF_W // DIFF_HEADS
DIFF_D = DIFF_DV // 2
CHUNK = 64
Q_BLOCK = 128
ROPE_THETA = 10000.0
EPS = 1e-6

IN_SPLITS = (
    GLA_HEADS * GLA_DK, GLA_HEADS * GLA_DK, GLA_W, GLA_RANK, GLA_W,
    GDN_W, GDN_W, GDN_W, GDN_HEADS, GDN_HEADS, GDN_W,
    DIFF_HEADS * 2 * DIFF_D, DIFF_HEADS * 2 * DIFF_D, DIFF_W, DIFF_W,
)
D_IN = sum(IN_SPLITS)

kernel_name = "hybrid_gla_gdn_diffattn_parallel_heads"


def rms_norm(x, w):
    xf = x.astype(jnp.float32)
    y = xf * lax.rsqrt(jnp.mean(xf * xf, axis=-1, keepdims=True) + EPS)
    return (y * w.astype(jnp.float32)).astype(x.dtype)


def l2_norm(x):
    xf = x.astype(jnp.float32)
    return xf * lax.rsqrt(jnp.sum(xf * xf, axis=-1, keepdims=True) + EPS)


def rope_tables(positions, dim):
    half = dim // 2
    inv_freq = ROPE_THETA ** (-jnp.arange(half, dtype=jnp.float32) / half)
    ang = positions.astype(jnp.float32)[..., None] * inv_freq
    return jnp.cos(ang), jnp.sin(ang)


def apply_rope(x, cos, sin):
    xf = x.astype(jnp.float32)
    x1, x2 = jnp.split(xf, 2, axis=-1)
    return jnp.concatenate([x1 * cos - x2 * sin, x2 * cos + x1 * sin], axis=-1).astype(x.dtype)


def causal_depthwise_conv(x, w):
    C = x.shape[-1]
    return lax.conv_general_dilated(x, w[:, None, :].astype(x.dtype), window_strides=(1,),
                                    padding=[(CONV_K - 1, 0)], dimension_numbers=('NWC', 'WIO', 'NWC'),
                                    feature_group_count=C)


def _to_chunks(t, B, N, H):
    t = t.astype(jnp.float32)
    return jnp.moveaxis(t.reshape((B, N, CHUNK, H) + t.shape[3:]), 3, 1)


def gla_chunked(q, k, v, log_a):
    B, S, H, DK = q.shape
    DV = v.shape[-1]
    N = S // CHUNK
    q = _to_chunks(q, B, N, H) * DK ** -0.5
    k = _to_chunks(k, B, N, H)
    v = _to_chunks(v, B, N, H)
    b = jnp.cumsum(_to_chunks(log_a, B, N, H), axis=3)
    q_e = q * jnp.exp(b)
    k_e = k * jnp.exp(-b)
    causal = jnp.tril(jnp.ones((CHUNK, CHUNK), dtype=bool))
    att = jnp.where(causal, jnp.einsum('bhncd,bhnsd->bhncs', q_e, k_e), 0.0)
    o_intra = jnp.einsum('bhncs,bhnsv->bhncv', att, v)
    b_last = b[:, :, :, -1:, :]
    d_state = jnp.einsum('bhncd,bhncv->bhndv', k * jnp.exp(b_last - b), v)
    decay = jnp.exp(b_last[:, :, :, 0, :])

    def step(state, inp):
        ds_n, dec_n = inp
        return dec_n[..., None] * state + ds_n, state

    s0 = jnp.zeros((B, H, DK, DV), jnp.float32)
    _, s_prev = lax.scan(step, s0, (jnp.moveaxis(d_state, 2, 0), jnp.moveaxis(decay, 2, 0)))
    s_prev = jnp.moveaxis(s_prev, 0, 2)
    o = o_intra + jnp.einsum('bhncd,bhndv->bhncv', q_e, s_prev)
    return jnp.moveaxis(o, 1, 3).reshape(B, S, H, DV)


def gated_delta_chunked(q, k, v, g, beta):
    B, S, H, DK = q.shape
    DV = v.shape[-1]
    N = S // CHUNK
    q = _to_chunks(q, B, N, H) * DK ** -0.5
    k = _to_chunks(k, B, N, H)
    v = _to_chunks(v, B, N, H)
    gc = jnp.cumsum(_to_chunks(g, B, N, H), axis=-1)
    beta = _to_chunks(beta, B, N, H)
    incl = jnp.tril(jnp.ones((CHUNK, CHUNK), dtype=bool))
    strict = jnp.tril(jnp.ones((CHUNK, CHUNK), dtype=bool), k=-1)
    decay = jnp.exp(jnp.where(incl, gc[..., :, None] - gc[..., None, :], -jnp.inf))
    k_beta = k * beta[..., None]
    v_beta = v * beta[..., None]
    lower = jnp.where(strict, jnp.einsum('bhncd,bhnsd->bhncs', k_beta, k) * decay, 0.0)
    eye = jnp.eye(CHUNK, dtype=jnp.float32)
    rhs = jnp.concatenate([v_beta, k_beta * jnp.exp(gc)[..., None]], axis=-1)
    sol = lax.linalg.triangular_solve(eye + lower, rhs, left_side=True, lower=True, unit_diagonal=True)
    u, w = sol[..., :DV], sol[..., DV:]
    qk = jnp.einsum('bhncd,bhnsd->bhncs', q, k) * decay
    q_e = q * jnp.exp(gc)[..., None]
    k_tail = k * jnp.exp(gc[..., -1:] - gc)[..., None]
    chunk_decay = jnp.exp(gc[..., -1])

    def step(state, inp):
        u_n, w_n, qe_n, qk_n, kt_n, cd_n = inp
        v_new = u_n - jnp.einsum('bhck,bhkv->bhcv', w_n, state)
        o_n = jnp.einsum('bhck,bhkv->bhcv', qe_n, state) + jnp.einsum('bhcs,bhsv->bhcv', qk_n, v_new)
        state = state * cd_n[..., None, None] + jnp.einsum('bhck,bhcv->bhkv', kt_n, v_new)
        return state, o_n

    xs = tuple(jnp.moveaxis(t, 2, 0) for t in (u, w, q_e, qk, k_tail, chunk_decay))
    s0 = jnp.zeros((B, H, DK, DV), jnp.float32)
    _, o = lax.scan(step, s0, xs)
    o = jnp.moveaxis(o, 0, 2)
    return jnp.moveaxis(o, 1, 3).reshape(B, S, H, DV)


def diff_attention(q, k, v, lam):
    B, H, _, S, D = q.shape
    nb = S // Q_BLOCK
    scale = D ** -0.5
    q_blocks = jnp.moveaxis(q.reshape(B, H, 2, nb, Q_BLOCK, D), 3, 0)
    key_idx = jnp.arange(S)

    def block(args):
        qb, i = args
        s = jnp.einsum('bhmqd,bhmkd->bhmqk', qb, k).astype(jnp.float32) * scale
        q_idx = i * Q_BLOCK + jnp.arange(Q_BLOCK)
        s = jnp.where(key_idx[None, :] <= q_idx[:, None], s, -jnp.inf)
        p = jax.nn.softmax(s, axis=-1)
        a = p[:, :, 0] - lam * p[:, :, 1]
        return jnp.einsum('bhqk,bhkv->bhqv', a.astype(v.dtype), v)

    out = lax.map(block, (q_blocks, jnp.arange(nb)))
    return jnp.moveaxis(out, 0, 2).reshape(B, H, S, v.shape[-1])


def setup_inputs(seed: int = 0) -> dict:
    key = jax.random.key(seed)
    ks = jax.random.split(key, 20)
    f32 = jnp.float32
    x = jax.random.normal(ks[0], (BATCH, SEQ, D_MODEL), f32)
    c = jax.random.normal(ks[1], (BATCH, D_MODEL), f32)
    offsets = jax.random.randint(ks[2], (BATCH, 1), 0, 4096, dtype=jnp.int32)
    positions = offsets + jnp.arange(SEQ, dtype=jnp.int32)[None, :]
    norm_w = 1.0 + 0.02 * jax.random.normal(ks[3], (DEPTH, D_MODEL), f32)
    w_ada = jax.random.normal(ks[4], (DEPTH, D_MODEL, 3 * D_MODEL), f32) * D_MODEL ** -0.5
    b_ada = 0.01 * jax.random.normal(ks[5], (DEPTH, 3 * D_MODEL), f32)
    w_in = jax.random.normal(ks[6], (DEPTH, D_MODEL, D_IN), f32) * D_MODEL ** -0.5
    gla_w_lr = jax.random.normal(ks[7], (DEPTH, GLA_RANK, GLA_HEADS * GLA_DK), f32) * GLA_RANK ** -0.5
    gla_b_lr = 0.01 * jax.random.normal(ks[8], (DEPTH, GLA_HEADS * GLA_DK), f32)
    gla_norm_w = 1.0 + 0.02 * jax.random.normal(ks[9], (DEPTH, GLA_DV), f32)
    gdn_conv_w = jax.random.normal(ks[10], (DEPTH, CONV_K, 3 * GDN_W), f32) * CONV_K ** -0.5
    gdn_a_log = jnp.log(jax.random.uniform(ks[11], (DEPTH, GDN_HEADS), f32, 1.0, 16.0))
    dt = jnp.exp(jax.random.uniform(ks[12], (DEPTH, GDN_HEADS), f32, math.log(1e-3), math.log(1e-1)))
    gdn_dt_bias = dt + jnp.log(-jnp.expm1(-dt))
    gdn_norm_w = 1.0 + 0.02 * jax.random.normal(ks[13], (DEPTH, GDN_D), f32)
    diff_q_norm_w = 1.0 + 0.02 * jax.random.normal(ks[14], (DEPTH, DIFF_D), f32)
    diff_k_norm_w = 1.0 + 0.02 * jax.random.normal(ks[15], (DEPTH, DIFF_D), f32)
    diff_lambda = 0.1 * jax.random.normal(ks[16], (DEPTH, 4, DIFF_D), f32)
    diff_norm_w = 1.0 + 0.02 * jax.random.normal(ks[17], (DEPTH, DIFF_DV), f32)
    w_out = jax.random.normal(ks[18], (DEPTH, D_MIX, D_MODEL), f32) * D_MIX ** -0.5
    return {"x": x, "c": c, "positions": positions, "norm_w": norm_w, "w_ada": w_ada, "b_ada": b_ada,
            "w_in": w_in, "gla_w_lr": gla_w_lr, "gla_b_lr": gla_b_lr, "gla_norm_w": gla_norm_w,
            "gdn_conv_w": gdn_conv_w, "gdn_a_log": gdn_a_log, "gdn_dt_bias": gdn_dt_bias, "gdn_norm_w": gdn_norm_w,
            "diff_q_norm_w": diff_q_norm_w, "diff_k_norm_w": diff_k_norm_w, "diff_lambda": diff_lambda,
            "diff_norm_w": diff_norm_w, "w_out": w_out}


def reference(x, c, positions, norm_w, w_ada, b_ada, w_in, gla_w_lr, gla_b_lr, gla_norm_w,
              gdn_conv_w, gdn_a_log, gdn_dt_bias, gdn_norm_w, diff_q_norm_w, diff_k_norm_w, diff_lambda,
              diff_norm_w, w_out):
    B, S, _ = x.shape
    cos, sin = rope_tables(positions, DIFF_D)
    cos_b, sin_b = cos[:, None, None], sin[:, None, None]
    bounds = np.cumsum(IN_SPLITS)[:-1].tolist()
    c_act = jax.nn.silu(c)

    for l in range(DEPTH):
        shift, scale, gate = jnp.split(c_act @ w_ada[l] + b_ada[l], 3, axis=-1)
        h = rms_norm(x, norm_w[l]) * (1.0 + scale[:, None, :]) + shift[:, None, :]
        (gq, gk, gv, glr, gz, dq, dk, dv, da, db, dz, aq, ak, av, az) = jnp.split(h @ w_in[l], bounds, axis=-1)

        log_a = jax.nn.log_sigmoid((glr @ gla_w_lr[l] + gla_b_lr[l]).astype(jnp.float32)) / GLA_TAU
        o_gla = gla_chunked(gq.reshape(B, S, GLA_HEADS, GLA_DK), gk.reshape(B, S, GLA_HEADS, GLA_DK),
                            gv.reshape(B, S, GLA_HEADS, GLA_DV), log_a.reshape(B, S, GLA_HEADS, GLA_DK))
        o_gla = (rms_norm(o_gla, gla_norm_w[l]).reshape(B, S, GLA_W) * jax.nn.silu(gz)).astype(x.dtype)

        qkv = jax.nn.silu(causal_depthwise_conv(jnp.concatenate([dq, dk, dv], axis=-1), gdn_conv_w[l]))
        cq, ck, cv = jnp.split(qkv, 3, axis=-1)
        g = -jnp.exp(gdn_a_log[l].astype(jnp.float32)) * jax.nn.softplus(
            (da + gdn_dt_bias[l]).astype(jnp.float32))
        beta = jax.nn.sigmoid(db.astype(jnp.float32))
        o_gdn = gated_delta_chunked(l2_norm(cq.reshape(B, S, GDN_HEADS, GDN_D)),
                                    l2_norm(ck.reshape(B, S, GDN_HEADS, GDN_D)),
                                    cv.reshape(B, S, GDN_HEADS, GDN_D), g, beta)
        o_gdn = (rms_norm(o_gdn, gdn_norm_w[l]).reshape(B, S, GDN_W) * jax.nn.silu(dz)).astype(x.dtype)

        q_d = rms_norm(aq.reshape(B, S, DIFF_HEADS, 2, DIFF_D), diff_q_norm_w[l]).transpose(0, 2, 3, 1, 4)
        k_d = rms_norm(ak.reshape(B, S, DIFF_HEADS, 2, DIFF_D), diff_k_norm_w[l]).transpose(0, 2, 3, 1, 4)
        q_d = apply_rope(q_d, cos_b, sin_b)
        k_d = apply_rope(k_d, cos_b, sin_b)
        v_d = av.reshape(B, S, DIFF_HEADS, DIFF_DV).transpose(0, 2, 1, 3)
        lam_init = 0.8 - 0.6 * math.exp(-0.3 * l)
        lv = diff_lambda[l].astype(jnp.float32)
        lam = jnp.exp(jnp.sum(lv[0] * lv[1])) - jnp.exp(jnp.sum(lv[2] * lv[3])) + lam_init
        o_diff = diff_attention(q_d, k_d, v_d, lam)
        o_diff = rms_norm(o_diff, diff_norm_w[l]) * (1.0 - lam_init)
        o_diff = (o_diff.transpose(0, 2, 1, 3).reshape(B, S, DIFF_W) * jax.nn.silu(az)).astype(x.dtype)

        y = jnp.concatenate([o_gla, o_gdn, o_diff], axis=-1) @ w_out[l]
        x = x + gate[:, None, :] * y
    return x
```

```cpp
#include <hip/hip_runtime.h>
#include <hip/hip_cooperative_groups.h>
#include <cstdio>
namespace cg = cooperative_groups;

#define DI __device__ __forceinline__
#define LAS __attribute__((address_space(3)))
typedef unsigned short bf16_t;
typedef short bf16x8 __attribute__((ext_vector_type(8)));
typedef float f32x4 __attribute__((ext_vector_type(4)));
typedef float f32x2 __attribute__((ext_vector_type(2)));
typedef unsigned u32x4 __attribute__((ext_vector_type(4)));
typedef unsigned u32x2 __attribute__((ext_vector_type(2)));

constexpr int TT = 8192, DM = 2048, SEQ = 2048, DIN = 7704, NPROJ = 7680, NPAD = 7936;
constexpr int LDS_BYTES = 160 * 1024;
#ifndef PROBE_PHASE
#define PROBE_PHASE 0
#endif

struct Params {
    const float *x, *c; const int* pos;
    const float *norm_w, *w_ada, *b_ada, *w_in, *gla_w_lr, *gla_b_lr, *gla_norm_w, *gdn_conv_w, *gdn_a_log, *gdn_dt_bias,
        *gdn_norm_w, *diff_q_norm_w, *diff_k_norm_w, *diff_lambda, *diff_norm_w, *w_out;
    float* out;
    bf16_t *WinT, *WoutT, *hbuf, *proj, *concat;
    float *mod, *rope, *lam, *small, *x1;
    unsigned* cnt; unsigned* bar;
    bf16_t *gqe, *gatt, *gkdT, *gvT; float *gdec, *ogla;
    float *du; bf16_t *dw, *dqe, *dktT, *dqk; float *dcd, *ogdn;
    bf16_t *qd, *kd, *vT;
};

typedef const __attribute__((address_space(4))) unsigned char* KP4;
DI int get_tid() { int t = threadIdx.x; asm volatile("" : "+v"(t)); return t; }
DI int get_bid() { int b = blockIdx.x; asm volatile("" : "+s"(b)); return b; }
DI Params load_params() { KP4 q = (KP4)__builtin_amdgcn_kernarg_segment_ptr(); asm volatile("" : "+s"(q)); Params r; __builtin_memcpy(&r, q, sizeof(Params)); return r; }
typedef __bf16 bf16x2_t __attribute__((ext_vector_type(2)));
DI unsigned cvt_pk_bf16(float lo, float hi) { const f32x2 v = {lo, hi}; const bf16x2_t r = __builtin_convertvector(v, bf16x2_t); return __builtin_bit_cast(unsigned, r); }
DI float bf_lo(unsigned u) { return __uint_as_float(u << 16); }
DI float bf_hi(unsigned u) { return __uint_as_float(u & 0xffff0000u); }
DI float bf2f(bf16_t v) { return __uint_as_float(((unsigned)v) << 16); }
DI float siluf(float x) { return x / (1.f + __expf(-x)); }
DI float xch16_max(float x) { const unsigned u = __float_as_uint(x); const u32x2 r = __builtin_amdgcn_permlane16_swap(u, u, false, false); return fmaxf(__uint_as_float(r[0]), __uint_as_float(r[1])); }
DI float xch32_max(float x) { const unsigned u = __float_as_uint(x); const u32x2 r = __builtin_amdgcn_permlane32_swap(u, u, false, false); return fmaxf(__uint_as_float(r[0]), __uint_as_float(r[1])); }
DI float xch16_add(float x) { const unsigned u = __float_as_uint(x); const u32x2 r = __builtin_amdgcn_permlane16_swap(u, u, false, false); return __uint_as_float(r[0]) + __uint_as_float(r[1]); }
DI float xch32_add(float x) { const unsigned u = __float_as_uint(x); const u32x2 r = __builtin_amdgcn_permlane32_swap(u, u, false, false); return __uint_as_float(r[0]) + __uint_as_float(r[1]); }
template <int CTRL> DI float dpp_f(float x) { return __int_as_float(__builtin_amdgcn_update_dpp(0, __float_as_int(x), CTRL, 0xf, 0xf, false)); }
DI float sum4(float x) { x += dpp_f<0xB1>(x); x += dpp_f<0x4E>(x); return x; }
DI float sum16(float x) { x = sum4(x); x += dpp_f<0x141>(x); x += dpp_f<0x140>(x); return x; }
DI f32x4 mfma16(bf16x8 a, bf16x8 b, f32x4 c) { return __builtin_amdgcn_mfma_f32_16x16x32_bf16(a, b, c, 0, 0, 0); }
DI bf16x8 as_bf16x8(u32x4 v) { return __builtin_bit_cast(bf16x8, v); }

namespace pg8 {
constexpr int BM = 256, BK = 64, HALF = 128, HTB = HALF * BK * 2, STAGE_BYTES = 8 * HTB, NXCD = 8, WGM = 8;
DI int lds_byte(int r, int c) { const int st = (r >> 4) * 2 + (c >> 5), rr = r & 15, cc = c & 31, ob = rr * 64 + cc * 2; return st * 1024 + (ob ^ (((ob >> 9) & 1) << 5)); }
DI void stage_rc(int b, int& R, int& C) { const int st = b / 1024, sb = b % 1024, swz = sb ^ (((sb >> 9) & 1) << 5); R = (st >> 1) * 16 + swz / 64; C = (st & 1) * 32 + (swz % 64) / 2; }
DI int perm32(int rho) { const int n = rho >> 4, i = rho & 15; return 8 * (i >> 2) + 4 * n + (i & 3); }
struct Unit { int pm, pn; };
struct Gemm { const bf16_t* A; const bf16_t* Bt; int M, N, K; };
struct StaticOrder {
    int nM, nN, nwg, G, c;
    DI void init(int M, int N, int G_, int c_) { nM = M / BM; nN = N / BM; nwg = nM * nN; G = G_; c = c_; }
    DI bool next(int i, Unit& u) const {
        const long L = (long)i * G + c; if (L >= nwg) return false;
        int wgid = (int)L; { const int q = nwg / NXCD, r = nwg % NXCD, xcd = wgid % NXCD, off = wgid / NXCD; wgid = (xcd < r ? xcd * (q + 1) : r * (q + 1) + (xcd - r) * q) + off; }
        const int nig = WGM * nN, gid = wgid / nig, fm = gid * WGM, gsz = (nM - fm) < WGM ? (nM - fm) : WGM;
        u.pm = fm + ((wgid % nig) % gsz); u.pn = (wgid % nig) / gsz; return true;
    }
};

template <class Epi>
DI void gemm_phase(LAS unsigned char* lds, const Gemm g, const StaticOrder& S, const Epi& E) {
    const int tid = get_tid(), wid = __builtin_amdgcn_readfirstlane(tid >> 6), lane = tid & 63, wr = wid >> 2, wc = wid & 3, fr = lane & 15, fq = lane >> 4;
    const int K = g.K, nt = K / BK;
    unsigned voffA[2], voffB[2];
#pragma unroll
    for (int i = 0; i < 2; ++i) { int R, C; stage_rc(tid * 16 + i * 8192, R, C); const int Rb = Epi::PERM ? ((R & ~31) + perm32(R & 31)) : R;
        voffA[i] = (unsigned)(R * K + C) * 2u; voffB[i] = (unsigned)(Rb * K + C) * 2u; }
    const size_t kstep = (size_t)(BK * 2);
    const size_t hstep = (size_t)HALF * K * 2;
    const size_t tstep = 2 * hstep;
    const unsigned ldsw = (unsigned)wid * 1024u;
    const int aoff = lds_byte(wr * 64 + fr, fq * 8), boff = lds_byte(wc * 32 + fr, fq * 8);
#define PG8_SA(b, h) (((b) * 2 + (h)) * HTB)
#define PG8_SB(b, h) ((4 + (b) * 2 + (h)) * HTB)
#define PG8_STAGE(bufoff, gbase, voff) do { _Pragma("unroll") for (int _i = 0; _i < 2; ++_i) \
        __builtin_amdgcn_global_load_lds((const unsigned*)((const char*)(gbase) + (voff)[_i]), (LAS unsigned*)(lds + (bufoff) + ldsw + _i * 8192), 16, 0, 0); } while (0)
#define PG8_LDA(dst, b, h) do { _Pragma("unroll") for (int m = 0; m < 4; ++m) _Pragma("unroll") for (int k = 0; k < 2; ++k) dst[m][k] = *(const LAS bf16x8*)(lds + PG8_SA(b, h) + aoff + m * 2048 + k * 1024); } while (0)
#define PG8_LDB(dst, b, h) do { _Pragma("unroll") for (int n = 0; n < 2; ++n) _Pragma("unroll") for (int k = 0; k < 2; ++k) dst[n][k] = *(const LAS bf16x8*)(lds + PG8_SB(b, h) + boff + n * 2048 + k * 1024); } while (0)
#define PG8_MMA(ai, bj, At, Bt) do { __builtin_amdgcn_s_setprio(1); _Pragma("unroll") for (int m = 0; m < 4; ++m) _Pragma("unroll") for (int n = 0; n < 2; ++n) _Pragma("unroll") for (int k = 0; k < 2; ++k) \
        acc[ai][bj][m][n] = __builtin_amdgcn_mfma_f32_16x16x32_bf16(Bt[n][k], At[m][k], acc[ai][bj][m][n], 0, 0, 0); __builtin_amdgcn_s_setprio(0); } while (0)
#define PG8_WAIT_V(n) asm volatile("s_waitcnt vmcnt(" #n ")" ::: "memory")
#define PG8_WAIT_L(n) asm volatile("s_waitcnt lgkmcnt(" #n ")" ::: "memory")
#define PG8_BAR __builtin_amdgcn_s_barrier()
#define PG8_SCHED __builtin_amdgcn_sched_barrier(0)
    Unit cur, nxt; int ui = 0;
    if (!S.next(0, cur)) return;
    f32x4 acc[2][2][4][2];
#pragma unroll
    for (int a = 0; a < 2; ++a)
#pragma unroll
        for (int b = 0; b < 2; ++b)
#pragma unroll
            for (int m = 0; m < 4; ++m)
#pragma unroll
                for (int n = 0; n < 2; ++n) acc[a][b][m][n] = (f32x4){0.f, 0.f, 0.f, 0.f};
    bf16x8 At[4][2], B0[2][2], B1[2][2];
    const char* cA = (const char*)g.A + (size_t)cur.pm * tstep; const char* cB = (const char*)g.Bt + (size_t)cur.pn * tstep;
    PG8_STAGE(PG8_SB(0, 0), cB, voffB); PG8_STAGE(PG8_SA(0, 0), cA, voffA); PG8_STAGE(PG8_SB(0, 1), cB + hstep, voffB); PG8_STAGE(PG8_SA(0, 1), cA + hstep, voffA);
    if (wr == 1) PG8_BAR;
    PG8_WAIT_V(4); PG8_BAR;
    PG8_STAGE(PG8_SB(1, 0), cB + kstep, voffB); PG8_STAGE(PG8_SA(1, 0), cA + kstep, voffA); PG8_STAGE(PG8_SB(1, 1), cB + hstep + kstep, voffB);
    PG8_WAIT_V(6); PG8_BAR;
    for (;;) {
        const bool has_next = S.next(ui + 1, nxt);
        const char* nA = has_next ? (const char*)g.A + (size_t)nxt.pm * tstep : cA; const char* nB = has_next ? (const char*)g.Bt + (size_t)nxt.pn * tstep : cB;
        for (int t = 0; t < nt; t += 2) {
            const bool last = (t == nt - 2);
            const char* a1 = cA + (size_t)(t + 1) * kstep;
            const char* a2 = last ? nA : cA + (size_t)(t + 2) * kstep; const char* b2 = last ? nB : cB + (size_t)(t + 2) * kstep;
            const char* a3 = a2 + kstep; const char* b3 = b2 + kstep;
            PG8_LDB(B0, 0, 0); PG8_SCHED; PG8_LDA(At, 0, 0); PG8_STAGE(PG8_SA(1, 1), a1 + hstep, voffA);
            PG8_WAIT_L(8); PG8_BAR; PG8_WAIT_L(0); PG8_MMA(0, 0, At, B0); PG8_BAR; PG8_SCHED;
            PG8_LDB(B1, 0, 1); PG8_STAGE(PG8_SB(0, 0), b2, voffB);
            PG8_BAR; PG8_WAIT_L(0); PG8_MMA(0, 1, At, B1); PG8_BAR;
            PG8_LDA(At, 0, 1); PG8_STAGE(PG8_SA(0, 0), a2, voffA);
            PG8_BAR; PG8_WAIT_L(0); PG8_MMA(1, 0, At, B0); PG8_BAR; PG8_SCHED;
            PG8_STAGE(PG8_SB(0, 1), b2 + hstep, voffB);
            PG8_WAIT_V(6); PG8_BAR; PG8_MMA(1, 1, At, B1); PG8_BAR;
            PG8_LDB(B0, 1, 0); PG8_SCHED; PG8_LDA(At, 1, 0); PG8_STAGE(PG8_SA(0, 1), a2 + hstep, voffA);
            PG8_WAIT_L(8); PG8_BAR; PG8_WAIT_L(0); PG8_MMA(0, 0, At, B0); PG8_BAR; PG8_SCHED;
            PG8_LDB(B1, 1, 1); PG8_STAGE(PG8_SB(1, 0), b3, voffB);
            PG8_BAR; PG8_WAIT_L(0); PG8_MMA(0, 1, At, B1); PG8_BAR;
            PG8_LDA(At, 1, 1); PG8_STAGE(PG8_SA(1, 0), a3, voffA);
            PG8_BAR; PG8_WAIT_L(0); PG8_MMA(1, 0, At, B0); PG8_BAR; PG8_SCHED;
            PG8_STAGE(PG8_SB(1, 1), b3 + hstep, voffB);
            PG8_WAIT_V(6); PG8_BAR; PG8_MMA(1, 1, At, B1); PG8_BAR;
        }
        E(acc, cur, wr, wc, fr, fq);
        if (!has_next) break;
#pragma unroll
        for (int a = 0; a < 2; ++a)
#pragma unroll
            for (int b = 0; b < 2; ++b)
#pragma unroll
                for (int m = 0; m < 4; ++m)
#pragma unroll
                    for (int n = 0; n < 2; ++n) acc[a][b][m][n] = (f32x4){0.f, 0.f, 0.f, 0.f};
        cur = nxt; cA = nA; cB = nB; ++ui;
    }
    PG8_WAIT_V(0);
    if (wr == 0) PG8_BAR;
    PG8_BAR;
#undef PG8_SA
#undef PG8_SB
#undef PG8_STAGE
#undef PG8_LDA
#undef PG8_LDB
#undef PG8_MMA
#undef PG8_WAIT_V
#undef PG8_WAIT_L
#undef PG8_BAR
#undef PG8_SCHED
}
}

struct EpiProj {
    static constexpr bool PERM = true;
    bf16_t* proj; float* small;
    DI void operator()(const f32x4 (&acc)[2][2][4][2], const pg8::Unit& u, int wr, int wc, int fr, int fq) const {
        const int row0 = u.pm * 256 + wr * 64 + fr;
        if (u.pn < 30) {
            const int col0 = u.pn * 256 + wc * 32 + 8 * fq;
#pragma unroll
            for (int ai = 0; ai < 2; ++ai)
#pragma unroll
                for (int m = 0; m < 4; ++m) {
                    bf16_t* rowp = proj + (size_t)(row0 + ai * 128 + m * 16) * NPROJ + col0;
#pragma unroll
                    for (int bj = 0; bj < 2; ++bj) {
                        const f32x4 v0 = acc[ai][bj][m][0], v1 = acc[ai][bj][m][1];
                        u32x4 w; w.x = cvt_pk_bf16(v0[0], v0[1]); w.y = cvt_pk_bf16(v0[2], v0[3]); w.z = cvt_pk_bf16(v1[0], v1[1]); w.w = cvt_pk_bf16(v1[2], v1[3]);
                        *(u32x4*)(rowp + bj * 128) = w;
                    }
                }
        } else if (wc == 0) {
#pragma unroll
            for (int ai = 0; ai < 2; ++ai)
#pragma unroll
                for (int m = 0; m < 4; ++m) {
                    float* rowp = small + (size_t)(row0 + ai * 128 + m * 16) * 32 + 8 * fq;
                    *(f32x4*)(rowp) = acc[ai][0][m][0]; *(f32x4*)(rowp + 4) = acc[ai][0][m][1];
                }
        }
    }
};
struct EpiOut {
    static constexpr bool PERM = false;
    const float* xin; float* xout; const float* gate;
    DI void operator()(const f32x4 (&acc)[2][2][4][2], const pg8::Unit& u, int wr, int wc, int fr, int fq) const {
        const int row0 = u.pm * 256 + wr * 64 + fr, col0 = u.pn * 256 + wc * 32 + 4 * fq;
        const int b = (u.pm * 256) >> 11;
        f32x4 g[2][2];
#pragma unroll
        for (int bj = 0; bj < 2; ++bj)
#pragma unroll
            for (int n = 0; n < 2; ++n) g[bj][n] = *(const f32x4*)(gate + b * 6144 + col0 + bj * 128 + n * 16);
#pragma unroll
        for (int ai = 0; ai < 2; ++ai)
#pragma unroll
            for (int mh = 0; mh < 2; ++mh) {
                f32x4 xv[2][2][2];
#pragma unroll
                for (int mm = 0; mm < 2; ++mm)
#pragma unroll
                    for (int bj = 0; bj < 2; ++bj)
#pragma unroll
                        for (int n = 0; n < 2; ++n)
                            xv[mm][bj][n] = *(const f32x4*)(xin + (size_t)(row0 + ai * 128 + (2 * mh + mm) * 16) * DM + col0 + bj * 128 + n * 16);
#pragma unroll
                for (int mm = 0; mm < 2; ++mm)
#pragma unroll
                    for (int bj = 0; bj < 2; ++bj)
#pragma unroll
                        for (int n = 0; n < 2; ++n)
                            *(f32x4*)(xout + (size_t)(row0 + ai * 128 + (2 * mh + mm) * 16) * DM + col0 + bj * 128 + n * 16) = xv[mm][bj][n] + g[bj][n] * acc[ai][bj][2 * mh + mm][n];
            }
    }
};

DI int orig_col(int j) {
    if (j < 1024) return j;
    if (j < 3072) return j + 16;
    if (j < 7680) return j + 24;
    if (j < 7696) return 1024 + (j - 7680);
    if (j < 7704) return 3088 + (j - 7696);
    return -1;
}
DI void transpose_tile(const float* src, int ldsrc, bf16_t* dst, int n0, int k0, bool remap, float* tile) {
    const int tid = get_tid(), nn = tid & 63, kb = tid >> 6;
    const int n = n0 + nn, oc = remap ? orig_col(n) : n;
    float v[32];
#pragma unroll
    for (int i = 0; i < 32; ++i) v[i] = oc >= 0 ? src[(size_t)(k0 + kb + 8 * i) * ldsrc + oc] : 0.f;
#pragma unroll
    for (int i = 0; i < 32; ++i) tile[(kb + 8 * i) * 65 + nn] = v[i];
    __syncthreads();
    const int r = tid >> 3, seg = tid & 7;
#pragma unroll
    for (int half = 0; half < 2; ++half) {
        unsigned pk[8];
#pragma unroll
        for (int j = 0; j < 8; ++j) pk[j] = cvt_pk_bf16(tile[(half * 128 + seg * 16 + 2 * j) * 65 + r], tile[(half * 128 + seg * 16 + 2 * j + 1) * 65 + r]);
        u32x4* d = (u32x4*)(dst + (size_t)(n0 + r) * 2048 + k0 + half * 128 + seg * 16);
        d[0] = (u32x4){pk[0], pk[1], pk[2], pk[3]}; d[1] = (u32x4){pk[4], pk[5], pk[6], pk[7]};
    }
    __syncthreads();
}
DI void adaln_item(const Params& p, int l, int cgp, float* lds) {
    const int tid = get_tid(), w = tid >> 6, lane = tid & 63;
    for (int i = tid; i < 8192; i += 512) { const float cv = p.c[i]; lds[i] = cv / (1.f + expf(-cv)); }
    __syncthreads();
    const int col = cgp * 64 + lane;
    const float* wp = p.w_ada + (size_t)l * 2048 * 6144 + col;
    float a0 = 0.f, a1 = 0.f, a2 = 0.f, a3 = 0.f;
    for (int k = w * 256; k < w * 256 + 256; k += 64) {
        float wv[64];
#pragma unroll
        for (int j = 0; j < 64; ++j) wv[j] = wp[(size_t)(k + j) * 6144];
#pragma unroll
        for (int j = 0; j < 64; ++j) { a0 += lds[k + j] * wv[j]; a1 += lds[2048 + k + j] * wv[j]; a2 += lds[4096 + k + j] * wv[j]; a3 += lds[6144 + k + j] * wv[j]; }
    }
    float* red = lds + 8192;
    red[(w * 4 + 0) * 64 + lane] = a0; red[(w * 4 + 1) * 64 + lane] = a1; red[(w * 4 + 2) * 64 + lane] = a2; red[(w * 4 + 3) * 64 + lane] = a3;
    __syncthreads();
    if (tid < 256) {
        const int b = tid >> 6; float s = 0.f;
#pragma unroll
        for (int ww = 0; ww < 8; ++ww) s += red[(ww * 4 + b) * 64 + lane];
        p.mod[(size_t)(l * 4 + b) * 6144 + col] = s + p.b_ada[l * 6144 + col];
    }
    __syncthreads();
}
DI void phase0(const Params& p, float* lds) {
    const int tid = get_tid();
    const int bid = get_bid();
    if (bid == 0 && tid < 64) p.cnt[tid] = 0u;
    if (bid == 1 && tid < 2) {
        const float* lv = p.diff_lambda + tid * 512; float s1 = 0.f, s2 = 0.f;
        for (int i = 0; i < 128; ++i) { s1 += lv[i] * lv[128 + i]; s2 += lv[256 + i] * lv[384 + i]; }
        const float lam_init = 0.8f - 0.6f * expf(-0.3f * (float)tid);
        p.lam[tid] = expf(s1) - expf(s2) + lam_init;
    }
    constexpr int N_ADA = 192, N_ROPE = 128, N_WIN = 124 * 8, N_WOUT = 32 * 8;
    constexpr int N_ITEMS = N_ADA + N_ROPE + 2 * (N_WIN + N_WOUT);
    for (int it = bid; it < N_ITEMS; it += gridDim.x) {
        if (it < N_ADA) { adaln_item(p, it / 96, it % 96, lds); }
        else if (it < N_ADA + N_ROPE) {
            const int t0 = (it - N_ADA) * 64;
            for (int e = tid; e < 64 * 64; e += 512) {
                const int t = t0 + (e >> 6), i = e & 63;
                const float inv = powf(10000.0f, -(float)i / 64.0f);
                const float ang = (float)p.pos[t] * inv;
                p.rope[(size_t)t * 128 + i] = cosf(ang); p.rope[(size_t)t * 128 + 64 + i] = sinf(ang);
            }
        } else {
            int j = it - N_ADA - N_ROPE; const int l = j / (N_WIN + N_WOUT); j -= l * (N_WIN + N_WOUT);
            if (j < N_WIN) transpose_tile(p.w_in + (size_t)l * 2048 * DIN, DIN, p.WinT + (size_t)l * NPAD * 2048, (j >> 3) * 64, (j & 7) * 256, true, lds);
            else { j -= N_WIN; transpose_tile(p.w_out + (size_t)l * 2048 * 2048, 2048, p.WoutT + (size_t)l * 2048 * 2048, (j >> 3) * 64, (j & 7) * 256, false, lds); }
        }
    }
}

DI void phase1(const Params& p, int l, const float* xin) {
    const int tid = get_tid(), w = tid >> 6, lane = tid & 63;
    const int nwav = gridDim.x * 8;
    for (int q = get_bid() * 8 + w; q < TT / 2; q += nwav) {
        const int b = q >> 10, r0 = b * 2048 + (q & 1023);
        const float* md = p.mod + (size_t)(l * 4 + b) * 6144;
        f32x4 v[2][8], nw[8], sh[8], sc[8];
#pragma unroll
        for (int u = 0; u < 2; ++u)
#pragma unroll
            for (int i = 0; i < 8; ++i) v[u][i] = *(const f32x4*)(xin + (size_t)(r0 + u * 1024) * DM + i * 256 + lane * 4);
#pragma unroll
        for (int i = 0; i < 8; ++i) {
            const int col = i * 256 + lane * 4;
            nw[i] = *(const f32x4*)(p.norm_w + l * 2048 + col); sh[i] = *(const f32x4*)(md + col); sc[i] = *(const f32x4*)(md + 2048 + col);
        }
        float ss[2] = {0.f, 0.f};
#pragma unroll
        for (int u = 0; u < 2; ++u) {
#pragma unroll
            for (int i = 0; i < 8; ++i) ss[u] += v[u][i][0] * v[u][i][0] + v[u][i][1] * v[u][i][1] + v[u][i][2] * v[u][i][2] + v[u][i][3] * v[u][i][3];
            ss[u] = sum16(ss[u]); ss[u] = xch16_add(ss[u]); ss[u] = xch32_add(ss[u]);
        }
#pragma unroll
        for (int u = 0; u < 2; ++u) {
            const float rstd = rsqrtf(ss[u] * (1.f / 2048.f) + 1e-6f);
#pragma unroll
            for (int i = 0; i < 8; ++i) {
                const f32x4 y = v[u][i] * rstd * nw[i] * (1.f + sc[i]) + sh[i];
                u32x2 o; o.x = cvt_pk_bf16(y[0], y[1]); o.y = cvt_pk_bf16(y[2], y[3]);
                *(u32x2*)(p.hbuf + (size_t)(r0 + u * 1024) * DM + i * 256 + lane * 4) = o;
            }
        }
    }
}

DI void gdn_prep(const Params& p, int l, int ci, unsigned char* lds, int stop) {
    const int tid = get_tid(), w = tid >> 6, lane = tid & 63, fr = lane & 15, q4 = lane >> 4;
    const int n = ci & 31, h = (ci >> 5) & 3, b = ci >> 7;
    const int t0 = b * SEQ + n * 64;
    constexpr int FS = 129;
    float* gcs = (float*)lds;
    float* bet = gcs + 64;
    float* rn = bet + 64;
    float* eg = rn + 128;
    float* egl = eg + 64;
    float* qf = egl + 64;
    float* kf = qf + 64 * FS;
    float* vf = kf + 64 * FS;
    float* Lm = vf + 64 * FS;
    bf16_t* qb = (bf16_t*)(Lm + 64 * 64);
    bf16_t* kb = qb + 64 * 136;
    bf16_t* raw = (bf16_t*)Lm;
    float cwt[3][4];
#pragma unroll
    for (int r = 0; r < 3; ++r) {
        const int chn = (tid + r * 512) % 384, seg = chn >> 7, d = chn & 127;
        const float* cw = p.gdn_conv_w + (size_t)l * 4 * 1536 + seg * 512 + h * 128 + d;
        cwt[r][0] = cw[0]; cwt[r][1] = cw[1536]; cwt[r][2] = cw[2 * 1536]; cwt[r][3] = cw[3 * 1536];
    }
    {
        u32x4 sv[7];
#pragma unroll
        for (int i = 0; i < 7; ++i) {
            const int e = tid + i * 512;
            const int row = e / 48, rem = e - row * 48, seg = rem >> 4, ch = rem & 15;
            sv[i] = (u32x4){0u, 0u, 0u, 0u};
            if (e < 67 * 48 && (n > 0 || row >= 3)) sv[i] = *(const u32x4*)(p.proj + (size_t)(t0 - 3 + row) * NPROJ + 1536 + seg * 512 + h * 128 + ch * 8);
        }
#pragma unroll
        for (int i = 0; i < 7; ++i) {
            const int e = tid + i * 512;
            const int row = e / 48, rem = e - row * 48, seg = rem >> 4, ch = rem & 15;
            if (e < 67 * 48) *(u32x4*)(raw + row * 384 + seg * 128 + ch * 8) = sv[i];
        }
    }
    if (tid < 64) {
        const int c = tid;
        const float da = p.small[(size_t)(t0 + c) * 32 + 16 + h], db = p.small[(size_t)(t0 + c) * 32 + 20 + h];
        const float xx = da + p.gdn_dt_bias[l * 4 + h];
        const float sp = xx > 20.f ? xx : log1pf(expf(xx));
        gcs[c] = -expf(p.gdn_a_log[l * 4 + h]) * sp;
        bet[c] = 1.f / (1.f + expf(-db));
    }
    __syncthreads();
#pragma unroll
    for (int r = 0; r < 3; ++r) {
        const int task = tid + r * 512;
        const int chn = task % 384, qt = task / 384;
        const int seg = chn >> 7, d = chn & 127;
        const float w0 = cwt[r][0], w1 = cwt[r][1], w2 = cwt[r][2], w3 = cwt[r][3];
        const bf16_t* rp = raw + (qt * 16) * 384 + seg * 128 + d;
        float xs[19];
#pragma unroll
        for (int c = 0; c < 19; ++c) xs[c] = bf2f(rp[c * 384]);
        float* dst = (seg == 0 ? qf : (seg == 1 ? kf : vf)) + (qt * 16) * FS + d;
#pragma unroll
        for (int c = 0; c < 16; ++c) {
            const float a = w0 * xs[c] + w1 * xs[c + 1] + w2 * xs[c + 2] + w3 * xs[c + 3];
            dst[c * FS] = a * __builtin_amdgcn_rcpf(1.f + __expf(-a));
        }
    }
    __syncthreads();
    if (stop == 1) return;
    {
        const int row = tid >> 2, sub = tid & 3;
        const float* src = (row < 64 ? qf + row * FS : kf + (row - 64) * FS);
        float s = 0.f;
        for (int i = 0; i < 32; ++i) { const float v = src[sub + 4 * i]; s += v * v; }
        s = sum4(s);
        if (sub == 0) rn[row] = rsqrtf(s + 1e-6f);
    }
    float gsum = 0.f;
    if (tid < 64) {
        gsum = gcs[tid];
#pragma unroll
        for (int o = 1; o < 64; o <<= 1) { const float t = __shfl_up(gsum, o); if (lane >= o) gsum += t; }
    }
    __syncthreads();
    if (tid < 64) gcs[tid] = gsum;
    { const float glast = __shfl(gsum, 63); if (tid < 64) { eg[tid] = __expf(gsum); egl[tid] = __expf(glast - gsum); } }
#pragma unroll 1
    for (int e0 = tid; e0 < 64 * 128; e0 += 4 * 512) {
        float qv[4], kv[4];
#pragma unroll
        for (int u = 0; u < 4; ++u) {
            const int e = e0 + u * 512, c = e >> 7, d = e & 127;
            qv[u] = qf[c * FS + d] * rn[c] * 0.08838834764831845f; kv[u] = kf[c * FS + d] * rn[64 + c];
        }
#pragma unroll
        for (int u = 0; u < 4; ++u) {
            const int e = e0 + u * 512, c = e >> 7, d = e & 127;
            qf[c * FS + d] = qv[u]; kf[c * FS + d] = kv[u];
            qb[c * 136 + d] = (bf16_t)(cvt_pk_bf16(qv[u], 0.f) & 0xffffu); kb[c * 136 + d] = (bf16_t)(cvt_pk_bf16(kv[u], 0.f) & 0xffffu);
        }
    }
    __syncthreads();
    {
        const int ct = w >> 1;
        const int c = ct * 16 + fr;
        const float gc_c = gcs[c], be_c = bet[c];
#pragma unroll
        for (int i = 0; i < 2; ++i) {
            const int st = (w & 1) * 2 + i;
            f32x4 akk = {0.f, 0.f, 0.f, 0.f}, aqk = {0.f, 0.f, 0.f, 0.f};
            if (st <= ct) {
#pragma unroll
                for (int ks = 0; ks < 4; ++ks) {
                    const bf16x8 ak = *(const bf16x8*)(kb + (st * 16 + fr) * 136 + ks * 32 + q4 * 8);
                    const bf16x8 bk = *(const bf16x8*)(kb + (ct * 16 + fr) * 136 + ks * 32 + q4 * 8);
                    const bf16x8 bq = *(const bf16x8*)(qb + (ct * 16 + fr) * 136 + ks * 32 + q4 * 8);
                    akk = mfma16(ak, bk, akk); aqk = mfma16(ak, bq, aqk);
                }
            }
            f32x4 lv, qv;
#pragma unroll
            for (int r = 0; r < 4; ++r) {
                const int s = st * 16 + q4 * 4 + r;
                const float dec = (s <= c) ? __expf(gc_c - gcs[s]) : 0.f;
                lv[r] = (s < c) ? be_c * akk[r] * dec : 0.f;
                qv[r] = aqk[r] * dec;
            }
            *(f32x4*)(Lm + c * 64 + st * 16 + q4 * 4) = lv;
            u32x2 o; o.x = cvt_pk_bf16(qv[0], qv[1]); o.y = cvt_pk_bf16(qv[2], qv[3]);
            *(u32x2*)(p.dqk + (size_t)ci * 4096 + c * 64 + st * 16 + q4 * 4) = o;
        }
    }
    __syncthreads();
    if (stop == 2) { __syncthreads(); return; }
    if (tid >= 256) {
        const int t2 = tid - 256;
#pragma unroll
        for (int i = 0; i < 4; ++i) {
            const int e = t2 + i * 256; const int c = e >> 4, d = (e & 15) * 8; const float egc = eg[c];
            const u32x4 r = *(const u32x4*)(qb + c * 136 + d);
            u32x4 o; o.x = cvt_pk_bf16(bf_lo(r.x) * egc, bf_hi(r.x) * egc); o.y = cvt_pk_bf16(bf_lo(r.y) * egc, bf_hi(r.y) * egc);
            o.z = cvt_pk_bf16(bf_lo(r.z) * egc, bf_hi(r.z) * egc); o.w = cvt_pk_bf16(bf_lo(r.w) * egc, bf_hi(r.w) * egc);
            *(u32x4*)(p.dqe + (size_t)ci * 8192 + c * 128 + d) = o;
        }
#pragma unroll
        for (int i = 0; i < 4; ++i) {
            const int e = t2 + i * 256; const int d = e & 127, c = (e >> 7) * 8;
            float kv[8];
#pragma unroll
            for (int j = 0; j < 8; ++j) kv[j] = bf2f(kb[(c + j) * 136 + d]) * egl[c + j];
            u32x4 o; o.x = cvt_pk_bf16(kv[0], kv[1]); o.y = cvt_pk_bf16(kv[2], kv[3]); o.z = cvt_pk_bf16(kv[4], kv[5]); o.w = cvt_pk_bf16(kv[6], kv[7]);
            *(u32x4*)(p.dktT + (size_t)ci * 8192 + d * 64 + c) = o;
        }
        if (t2 == 0) p.dcd[ci] = eg[63];
    } else if (stop != 3) {
        const int j = tid & 127; const bool isw = tid >= 128;
        float* X = (isw ? kf : vf) + j;
        int zoff; asm volatile("v_mov_b32 %0, 0" : "=v"(zoff));
        const float* Lz = Lm + zoff;
#pragma unroll 1
        for (int rb = 0; rb < 4; ++rb) {
            float a[16];
#pragma unroll
            for (int r = 0; r < 16; ++r) { const int i = rb * 16 + r; float v = X[i * FS] * bet[i]; if (isw) v *= eg[i]; a[r] = v; }
#pragma unroll 2
            for (int j4 = 0; j4 < rb * 4; ++j4) {
                const float x0 = X[(j4 * 4 + 0) * FS], x1 = X[(j4 * 4 + 1) * FS], x2 = X[(j4 * 4 + 2) * FS], x3 = X[(j4 * 4 + 3) * FS];
#pragma unroll
                for (int r = 0; r < 16; ++r) {
                    const f32x4 lv = *(const f32x4*)(Lz + (rb * 16 + r) * 64 + j4 * 4);
                    a[r] -= lv[0] * x0; a[r] -= lv[1] * x1; a[r] -= lv[2] * x2; a[r] -= lv[3] * x3;
                }
            }
#pragma unroll
            for (int r = 1; r < 16; ++r) {
#pragma unroll
                for (int r2 = 0; r2 < r; ++r2) a[r] -= Lz[(rb * 16 + r) * 64 + rb * 16 + r2] * a[r2];
            }
#pragma unroll
            for (int r = 0; r < 16; ++r) X[(rb * 16 + r) * FS] = a[r];
            if (!isw) {
#pragma unroll
                for (int r = 0; r < 16; ++r) p.du[(size_t)ci * 8192 + (rb * 16 + r) * 128 + j] = a[r];
            } else {
#pragma unroll
                for (int r = 0; r < 16; ++r) p.dw[(size_t)ci * 8192 + (rb * 16 + r) * 128 + j] = (bf16_t)(cvt_pk_bf16(a[r], 0.f) & 0xffffu);
            }
        }
    }
    __syncthreads();
}

DI void gla_prep(const Params& p, int l, int bn, unsigned char* lds) {
    const int tid = get_tid(), w = tid >> 6, lane = tid & 63, fr = lane & 15, q4 = lane >> 4;
    const int n = bn & 31, b = bn >> 5;
    const int t0 = b * SEQ + n * 64;
    float* glr = (float*)lds;
    float* bcum = glr + 64 * 16;
    bf16_t* qe_s = (bf16_t*)(bcum + 64 * 256);
    bf16_t* ke_s = qe_s + 64 * 72;
    bf16_t* kdT_s = ke_s + 64 * 72;
    bf16_t* vT_s = kdT_s + 64 * 72;
    u32x4 qr4[4], kr4[4], va4[4], vb4[4];
    {
        const int c = tid >> 3, ds = (tid & 7) * 8, dv0 = (tid & 7) * 16;
        const bf16_t* rowp = p.proj + (size_t)(t0 + c) * NPROJ;
#pragma unroll
        for (int h = 0; h < 4; ++h) {
            qr4[h] = *(const u32x4*)(rowp + h * 64 + ds); kr4[h] = *(const u32x4*)(rowp + 256 + h * 64 + ds);
            va4[h] = *(const u32x4*)(rowp + 512 + h * 128 + dv0); vb4[h] = *(const u32x4*)(rowp + 512 + h * 128 + dv0 + 8);
        }
    }
    float wl[16]; float bl;
#pragma unroll
    for (int r = 0; r < 16; ++r) wl[r] = p.gla_w_lr[(size_t)l * 16 * 256 + r * 256 + (tid & 255)];
    bl = p.gla_b_lr[l * 256 + (tid & 255)];
    if (tid < 256) { const int c = tid >> 2, r4 = (tid & 3) * 4; *(f32x4*)(glr + c * 16 + r4) = *(const f32x4*)(p.small + (size_t)(t0 + c) * 32 + r4); }
    __syncthreads();
    {
        const int col = tid & 255, c0 = (tid >> 8) * 32;
        float run = 0.f;
#pragma unroll 4
        for (int c = c0; c < c0 + 32; ++c) {
            float z = bl;
#pragma unroll
            for (int r = 0; r < 16; ++r) z += glr[c * 16 + r] * wl[r];
            const float la = (fminf(z, 0.f) - __logf(1.f + __expf(-fabsf(z)))) * (1.f / 16.f);
            run += la; bcum[c * 256 + col] = run;
        }
    }
    __syncthreads();
#pragma unroll
    for (int h = 0; h < 4; ++h) {
        const int ci = (b * 4 + h) * 32 + n;
        bf16_t* qe_h = qe_s + (h & 1) * 23040;
        bf16_t* ke_h = qe_h + 64 * 72;
        bf16_t* kdT_h = ke_h + 64 * 72;
        bf16_t* vT_h = kdT_h + 64 * 72;
        {
            const int c = tid >> 3, ds = (tid & 7) * 8, sw = (tid & 7) * 8;
            const u32x4 qr = qr4[h];
            const u32x4 kr = kr4[h];
            float qv[8], kv[8], bv[8], bl8[8];
#pragma unroll
            for (int j = 0; j < 4; ++j) { qv[2 * j] = bf_lo(qr[j]); qv[2 * j + 1] = bf_hi(qr[j]); kv[2 * j] = bf_lo(kr[j]); kv[2 * j + 1] = bf_hi(kr[j]); }
#pragma unroll
            for (int j = 0; j < 8; ++j) {
                const float t1 = bcum[31 * 256 + h * 64 + ds + j];
                bv[j] = bcum[c * 256 + h * 64 + ds + j] + (c >= 32 ? t1 : 0.f);
                bl8[j] = bcum[63 * 256 + h * 64 + ds + j] + t1;
            }
            u32x4 qo, ko;
#pragma unroll
            for (int j = 0; j < 4; ++j) {
                qo[j] = cvt_pk_bf16(qv[2 * j] * 0.125f * __expf(bv[2 * j]), qv[2 * j + 1] * 0.125f * __expf(bv[2 * j + 1]));
                ko[j] = cvt_pk_bf16(kv[2 * j] * __expf(-bv[2 * j]), kv[2 * j + 1] * __expf(-bv[2 * j + 1]));
            }
            *(u32x4*)(qe_h + c * 72 + ds) = qo; *(u32x4*)(ke_h + c * 72 + ds) = ko;
            *(u32x4*)(p.gqe + (size_t)ci * 4096 + c * 64 + ds) = qo;
#pragma unroll
            for (int j = 0; j < 8; ++j) kdT_h[(ds + j) * 72 + (c ^ sw)] = (bf16_t)(cvt_pk_bf16(kv[j] * __expf(bl8[j] - bv[j]), 0.f) & 0xffffu);
            const int dv0 = (tid & 7) * 16;
            const u32x4 v0 = va4[h];
            const u32x4 v1 = vb4[h];
#pragma unroll
            for (int j = 0; j < 4; ++j) {
                vT_h[(dv0 + 2 * j) * 72 + (c ^ sw)] = (bf16_t)(v0[j] & 0xffffu); vT_h[(dv0 + 2 * j + 1) * 72 + (c ^ sw)] = (bf16_t)(v0[j] >> 16);
                vT_h[(dv0 + 8 + 2 * j) * 72 + (c ^ sw)] = (bf16_t)(v1[j] & 0xffffu); vT_h[(dv0 + 8 + 2 * j + 1) * 72 + (c ^ sw)] = (bf16_t)(v1[j] >> 16);
            }
            if (tid < 64) p.gdec[(size_t)ci * 64 + tid] = __expf(bcum[63 * 256 + h * 64 + tid] + bcum[31 * 256 + h * 64 + tid]);
        }
        __syncthreads();
#pragma unroll
        for (int i = 0; i < 2; ++i) {
            const int id = w * 2 + i, ct = id >> 2, st = id & 3;
            f32x4 a = {0.f, 0.f, 0.f, 0.f};
            if (st <= ct) {
#pragma unroll
                for (int ks = 0; ks < 2; ++ks) {
                    const bf16x8 ak = *(const bf16x8*)(ke_h + (st * 16 + fr) * 72 + ks * 32 + q4 * 8);
                    const bf16x8 bq = *(const bf16x8*)(qe_h + (ct * 16 + fr) * 72 + ks * 32 + q4 * 8);
                    a = mfma16(ak, bq, a);
                }
            }
            const int c = ct * 16 + fr;
#pragma unroll
            for (int r = 0; r < 4; ++r) { const int s2 = st * 16 + q4 * 4 + r; if (s2 > c) a[r] = 0.f; }
            u32x2 o; o.x = cvt_pk_bf16(a[0], a[1]); o.y = cvt_pk_bf16(a[2], a[3]);
            *(u32x2*)(p.gatt + (size_t)ci * 4096 + c * 64 + st * 16 + q4 * 4) = o;
        }
        {
            const int r = tid >> 3, cs = (tid & 7) * 8;
            *(u32x4*)(p.gkdT + (size_t)ci * 4096 + r * 64 + cs) = *(const u32x4*)(kdT_h + r * 72 + (cs ^ (((r >> 3) & 7) * 8)));
            *(u32x4*)(p.gvT + (size_t)ci * 8192 + r * 64 + cs) = *(const u32x4*)(vT_h + r * 72 + (cs ^ (((r >> 4) & 7) * 8)));
            *(u32x4*)(p.gvT + (size_t)ci * 8192 + (64 + r) * 64 + cs) = *(const u32x4*)(vT_h + (64 + r) * 72 + (cs ^ ((((64 + r) >> 4) & 7) * 8)));
        }
    }
    __syncthreads();
}

DI void diff_prep(const Params& p, int l, int tile, unsigned char* lds) {
    const int tid = get_tid();
    const int t0 = tile * 64, b = t0 >> 11, s0 = t0 & 2047;
    bf16_t* vs = (bf16_t*)lds;
    {
        const int g = tid >> 4, i16 = tid & 15;
        const int d0 = i16 * 8, fi = (i16 & 7) * 8;
        float qw[8], kw[8];
#pragma unroll
        for (int j = 0; j < 8; ++j) { qw[j] = p.diff_q_norm_w[l * 128 + d0 + j]; kw[j] = p.diff_k_norm_w[l * 128 + d0 + j]; }
#pragma unroll 1
        for (int pass = 0; pass < 2; ++pass) {
            const int tk = pass * 32 + g, t = t0 + tk;
            const f32x4 cs0 = *(const f32x4*)(p.rope + (size_t)t * 128 + fi), cs1 = *(const f32x4*)(p.rope + (size_t)t * 128 + fi + 4);
            const f32x4 sn0 = *(const f32x4*)(p.rope + (size_t)t * 128 + 64 + fi), sn1 = *(const f32x4*)(p.rope + (size_t)t * 128 + 64 + fi + 4);
            u32x4 vreg[8];
#pragma unroll
            for (int i = 0; i < 8; ++i) { const int e = tid + (pass * 8 + i) * 512; vreg[i] = *(const u32x4*)(p.proj + (size_t)(t0 + (e >> 7)) * NPROJ + 5632 + (e & 127) * 8); }
            u32x4 raw16[16];
#pragma unroll
            for (int vec = 0; vec < 16; ++vec) raw16[vec] = *(const u32x4*)(p.proj + (size_t)t * NPROJ + 3584 + vec * 128 + d0);
#pragma unroll
            for (int i = 0; i < 8; ++i) { const int e = tid + (pass * 8 + i) * 512; *(u32x4*)(vs + (e >> 7) * 1032 + (e & 127) * 8) = vreg[i]; }
#pragma unroll
            for (int vec = 0; vec < 16; ++vec) {
                const int isk = vec >> 3, hm = vec & 7;
                float v[8];
#pragma unroll
                for (int j = 0; j < 4; ++j) { v[2 * j] = bf_lo(raw16[vec][j]); v[2 * j + 1] = bf_hi(raw16[vec][j]); }
                float ss = 0.f;
#pragma unroll
                for (int j = 0; j < 8; ++j) ss += v[j] * v[j];
                ss = sum16(ss);
                const float rstd = rsqrtf(ss * (1.f / 128.f) + 1e-6f);
                const float sc = isk ? 1.f : 0.08838834764831845f * 1.4426950408889634f;
                float o[8];
#pragma unroll
                for (int j = 0; j < 8; ++j) {
                    const float y = v[j] * rstd * (isk ? kw[j] : qw[j]);
                    const float oth = dpp_f<0x128>(y);
                    const float cs = (j < 4 ? cs0 : cs1)[j & 3], sn = (j < 4 ? sn0 : sn1)[j & 3];
                    o[j] = ((i16 < 8) ? (y * cs - oth * sn) : (y * cs + oth * sn)) * sc;
                }
                u32x4 ov; ov.x = cvt_pk_bf16(o[0], o[1]); ov.y = cvt_pk_bf16(o[2], o[3]); ov.z = cvt_pk_bf16(o[4], o[5]); ov.w = cvt_pk_bf16(o[6], o[7]);
                bf16_t* dst = (isk ? p.kd : p.qd) + ((size_t)((b * 8 + hm) * SEQ + s0 + tk)) * 128 + d0;
                *(u32x4*)dst = ov;
            }
        }
    }
    __syncthreads();
    {
        const int c2 = tid * 2, hh = c2 >> 8, dv = c2 & 255;
        bf16_t* dst = p.vT + ((size_t)((b * 4 + hh) * 32 + (s0 >> 6)) * 256 + dv) * 64;
#pragma unroll
        for (int seg = 0; seg < 8; ++seg) {
            unsigned wv[8];
#pragma unroll
            for (int j = 0; j < 8; ++j) wv[j] = *(const unsigned*)(vs + (seg * 8 + j) * 1032 + c2);
            u32x4 r0, r1;
#pragma unroll
            for (int j = 0; j < 4; ++j) { r0[j] = (wv[2 * j] & 0xffffu) | (wv[2 * j + 1] << 16); r1[j] = (wv[2 * j] >> 16) | (wv[2 * j + 1] & 0xffff0000u); }
            *(u32x4*)(dst + seg * 8) = r0; *(u32x4*)(dst + 64 + seg * 8) = r1;
        }
    }
    __syncthreads();
}

DI void phase3(const Params& p, int l, unsigned char* lds, int mask, int stop) {
    for (int it = get_bid(); it < 768; it += gridDim.x) {
        if (it < 512) { if (mask & 1) gdn_prep(p, l, it, lds, stop); }
        else if (it < 640) { if (mask & 2) gla_prep(p, l, it - 512, lds); }
        else if (mask & 4) diff_prep(p, l, it - 640, lds);
    }
}

DI void lds_barrier() { asm volatile("s_waitcnt lgkmcnt(0)" ::: "memory"); __builtin_amdgcn_s_barrier(); asm volatile("" ::: "memory"); }

struct GlaOps { bf16x8 att[2], vt[2][2], qe[2], kd[2]; f32x4 dec; };
DI void gla_load(const Params& p, size_t ci, int t2, int dh, int sl, int fr, int q4, GlaOps& o) {
    const bf16_t* att = p.gatt + ci * 4096 + (t2 * 16 + fr) * 64 + q4 * 8;
    const bf16_t* qe = p.gqe + ci * 4096 + (t2 * 16 + fr) * 64 + q4 * 8;
    const bf16_t* kdT = p.gkdT + ci * 4096 + (t2 * 16 + fr) * 64 + q4 * 8;
#pragma unroll
    for (int ks = 0; ks < 2; ++ks) { o.att[ks] = *(const bf16x8*)(att + ks * 32); o.qe[ks] = *(const bf16x8*)(qe + ks * 32); o.kd[ks] = *(const bf16x8*)(kdT + ks * 32); }
#pragma unroll
    for (int e = 0; e < 2; ++e) {
        const bf16_t* vT = p.gvT + ci * 8192 + (size_t)(sl * 64 + (2 * dh + e) * 16 + fr) * 64 + q4 * 8;
#pragma unroll
        for (int ks = 0; ks < 2; ++ks) o.vt[e][ks] = *(const bf16x8*)(vT + ks * 32);
    }
    o.dec = *(const f32x4*)(p.gdec + ci * 64 + t2 * 16 + q4 * 4);
}
DI void gla_chain(const Params& p, int id, unsigned char* lds) {
    const int tid = get_tid(), w = tid >> 6, lane = tid & 63, fr = lane & 15, q4 = lane >> 4;
    const int sl = id & 1, bh = id >> 1;
    bf16_t* St = (bf16_t*)lds;
    const int t2 = w >> 1, dh = w & 1;
    const int b = bh >> 2, h = bh & 3;
    f32x4 Sacc[2] = {{0.f, 0.f, 0.f, 0.f}, {0.f, 0.f, 0.f, 0.f}};
    auto step = [&](int n, const GlaOps& cur) {
#pragma unroll
        for (int e = 0; e < 2; ++e) { u32x2 o; o.x = cvt_pk_bf16(Sacc[e][0], Sacc[e][1]); o.y = cvt_pk_bf16(Sacc[e][2], Sacc[e][3]);
          *(u32x2*)(St + ((2 * dh + e) * 16 + fr) * 72 + t2 * 16 + q4 * 4) = o; }
        lds_barrier();
#pragma unroll
        for (int e = 0; e < 2; ++e) {
            f32x4 o = {0.f, 0.f, 0.f, 0.f};
#pragma unroll
            for (int ks = 0; ks < 2; ++ks) o = mfma16(cur.att[ks], cur.vt[e][ks], o);
#pragma unroll
            for (int ks = 0; ks < 2; ++ks) {
                const bf16x8 bs = *(const bf16x8*)(St + ((2 * dh + e) * 16 + fr) * 72 + ks * 32 + q4 * 8);
                o = mfma16(cur.qe[ks], bs, o);
            }
            float* dst = p.ogla + (size_t)(b * SEQ + n * 64 + t2 * 16 + q4 * 4) * 512 + h * 128 + sl * 64 + (2 * dh + e) * 16 + fr;
#pragma unroll
            for (int r = 0; r < 4; ++r) dst[r * 512] = o[r];
            Sacc[e] = Sacc[e] * cur.dec;
#pragma unroll
            for (int ks = 0; ks < 2; ++ks) Sacc[e] = mfma16(cur.kd[ks], cur.vt[e][ks], Sacc[e]);
        }
        lds_barrier();
    };
    GlaOps r0, r1, r2;
    const size_t c0 = (size_t)bh * 32;
    gla_load(p, c0 + 0, t2, dh, sl, fr, q4, r0); gla_load(p, c0 + 1, t2, dh, sl, fr, q4, r1); gla_load(p, c0 + 2, t2, dh, sl, fr, q4, r2);
#pragma unroll 1
    for (int n = 0; n < 33; n += 3) {
        step(n, r0);     gla_load(p, c0 + min(n + 3, 31), t2, dh, sl, fr, q4, r0);
        step(n + 1, r1); gla_load(p, c0 + min(n + 4, 31), t2, dh, sl, fr, q4, r1);
        if (n + 2 < 32) { step(n + 2, r2); gla_load(p, c0 + min(n + 5, 31), t2, dh, sl, fr, q4, r2); }
    }
}

struct GdnOps { bf16x8 am[4], qk[2], kt[2]; float u[4][4]; float cd; };
DI void gdn_load(const Params& p, size_t ci, int w, int ct, int role, int sl, int fr, int q4, GdnOps& o) {
    const bf16_t* am = (role ? p.dqe : p.dw) + ci * 8192 + (ct * 16 + fr) * 128 + q4 * 8;
    const bf16_t* ktT = p.dktT + ci * 8192 + (w * 16 + fr) * 64 + q4 * 8;
#pragma unroll
    for (int ks = 0; ks < 4; ++ks) o.am[ks] = *(const bf16x8*)(am + ks * 32);
#pragma unroll
    for (int ks = 0; ks < 2; ++ks) o.kt[ks] = *(const bf16x8*)(ktT + ks * 32);
    if (role) {
        const bf16_t* qk = p.dqk + ci * 4096 + (ct * 16 + fr) * 64 + q4 * 8;
#pragma unroll
        for (int ks = 0; ks < 2; ++ks) o.qk[ks] = *(const bf16x8*)(qk + ks * 32);
    } else {
#pragma unroll
        for (int e = 0; e < 4; ++e) {
            const float* up = p.du + ci * 8192 + (size_t)(ct * 16 + q4 * 4) * 128 + sl * 64 + e * 16 + fr;
#pragma unroll
            for (int r = 0; r < 4; ++r) o.u[e][r] = up[r * 128];
        }
    }
    o.cd = p.dcd[ci];
}
DI void gdn_chain(const Params& p, int id, unsigned char* lds) {
    const int tid = get_tid(), w = __builtin_amdgcn_readfirstlane(tid >> 6), lane = tid & 63, fr = lane & 15, q4 = lane >> 4;
    const int sl = id & 1, bh = id >> 1;
    bf16_t* St = (bf16_t*)lds;
    bf16_t* VnT = St + 64 * 136;
    const int ct = w >> 1, role = w & 1;
    f32x4 S[4];
#pragma unroll
    for (int i = 0; i < 4; ++i) S[i] = (f32x4){0.f, 0.f, 0.f, 0.f};
    const int b = bh >> 2, h = bh & 3;
    auto step = [&](int n, const GdnOps& cur) {
#pragma unroll
        for (int d = 0; d < 4; ++d) { u32x2 o; o.x = cvt_pk_bf16(S[d][0], S[d][1]); o.y = cvt_pk_bf16(S[d][2], S[d][3]);
          *(u32x2*)(St + (d * 16 + fr) * 136 + w * 16 + q4 * 4) = o; }
        lds_barrier();
        f32x4 acc[4];
#pragma unroll
        for (int e = 0; e < 4; ++e) {
            acc[e] = (f32x4){0.f, 0.f, 0.f, 0.f};
#pragma unroll
            for (int ks = 0; ks < 4; ++ks) {
                const bf16x8 bs = *(const bf16x8*)(St + (e * 16 + fr) * 136 + ks * 32 + q4 * 8);
                acc[e] = mfma16(cur.am[ks], bs, acc[e]);
            }
        }
        if (role == 0) {
#pragma unroll
            for (int e = 0; e < 4; ++e) {
                u32x2 pk; pk.x = cvt_pk_bf16(cur.u[e][0] - acc[e][0], cur.u[e][1] - acc[e][1]); pk.y = cvt_pk_bf16(cur.u[e][2] - acc[e][2], cur.u[e][3] - acc[e][3]);
                *(u32x2*)(VnT + (e * 16 + fr) * 72 + ct * 16 + q4 * 4) = pk;
            }
        }
        lds_barrier();
        if (role == 1) {
#pragma unroll
            for (int e = 0; e < 4; ++e) {
#pragma unroll
                for (int ks = 0; ks < 2; ++ks) { const bf16x8 bo = *(const bf16x8*)(VnT + (e * 16 + fr) * 72 + ks * 32 + q4 * 8); acc[e] = mfma16(cur.qk[ks], bo, acc[e]); }
                float* dst = p.ogdn + (size_t)(b * SEQ + n * 64 + ct * 16 + q4 * 4) * 512 + h * 128 + sl * 64 + e * 16 + fr;
#pragma unroll
                for (int r = 0; r < 4; ++r) dst[r * 512] = acc[e][r];
            }
        }
#pragma unroll
        for (int d = 0; d < 4; ++d) {
            S[d] = S[d] * cur.cd;
#pragma unroll
            for (int ks = 0; ks < 2; ++ks) { const bf16x8 bv = *(const bf16x8*)(VnT + (d * 16 + fr) * 72 + ks * 32 + q4 * 8); S[d] = mfma16(cur.kt[ks], bv, S[d]); }
        }
    };
    GdnOps r0, r1;
    const size_t c0 = (size_t)bh * 32;
    gdn_load(p, c0 + 0, w, ct, role, sl, fr, q4, r0); gdn_load(p, c0 + 1, w, ct, role, sl, fr, q4, r1);
#pragma unroll 1
    for (int n = 0; n < 32; n += 2) {
        step(n, r0);     gdn_load(p, c0 + min(n + 2, 31), w, ct, role, sl, fr, q4, r0);
        step(n + 1, r1); gdn_load(p, c0 + min(n + 3, 31), w, ct, role, sl, fr, q4, r1);
    }
    __syncthreads();
}

DI void attn_item(const Params& p, int l, int item, unsigned char* lds, int ktmul) {
    const int tid = get_tid(), w = __builtin_amdgcn_readfirstlane(tid >> 6), lane = tid & 63, fr = lane & 15, q4 = lane >> 4;
    const int qb = 31 - (item >> 4), bh = item & 15, b = bh >> 2, h = bh & 3;
    const int m = w >> 2, rt = w & 3;
    const int q0 = qb * 64;
    const float lam = p.lam[l];
    LAS unsigned char* L = (LAS unsigned char*)lds;
    const bf16_t* qg = p.qd + ((size_t)((b * 8 + h * 2 + m) * SEQ + q0 + rt * 16 + fr)) * 128;
    bf16x8 qf[4];
#pragma unroll
    for (int ks = 0; ks < 4; ++ks) qf[ks] = *(const bf16x8*)(qg + ks * 32 + q4 * 8);
    const bf16_t* kg = p.kd + ((size_t)(b * 8 + h * 2) * SEQ) * 128;
    const bf16_t* vg = p.vT + ((size_t)(b * 4 + h) * 32) * 16384;
    unsigned koff[4], voff[4];
#pragma unroll
    for (int i = 0; i < 4; ++i) {
        const int gk = w * 4 + i;
        const int rk = gk * 4 + (lane >> 4), ck = (lane & 15) ^ ((rk & 3) | (((rk >> 3) & 3) << 2));
        koff[i] = (unsigned)(((rk >> 6) * SEQ + (rk & 63)) * 128 + ck * 8);
        const int gv = w * 4 + i;
        const int rv = gv * 8 + (lane >> 3), cv = (lane & 7) ^ ((rv >> 1) & 7);
        voff[i] = (unsigned)(rv * 64 + cv * 8);
    }
    auto issue_tile = [&](int kt, int buf) {
#pragma unroll
        for (int i = 0; i < 4; ++i) {
            __builtin_amdgcn_global_load_lds((const unsigned*)(kg + (size_t)kt * 64 * 128 + koff[i]), (LAS unsigned*)(L + buf * 65536 + (w * 4 + i) * 1024), 16, 0, 0);
            __builtin_amdgcn_global_load_lds((const unsigned*)(vg + (size_t)kt * 16384 + voff[i]), (LAS unsigned*)(L + buf * 65536 + 32768 + (w * 4 + i) * 1024), 16, 0, 0);
        }
    };
    f32x4 O[16];
#pragma unroll
    for (int i = 0; i < 16; ++i) O[i] = (f32x4){0.f, 0.f, 0.f, 0.f};
    float mrun = 0.f, lrun = 0.f;
    const int qglob = q0 + rt * 16 + fr;
    const int krow = (fr >> 2) * 8 + (fr & 3);
    const unsigned kro = (unsigned)((m * 64 + krow) * 256);
    const unsigned vro = (unsigned)(fr * 128);
    const int vsw = (fr >> 1) & 7;
    issue_tile(0, 0);
    for (int kt = 0; kt <= qb; ++kt) {
        asm volatile("s_waitcnt vmcnt(0)" ::: "memory");
        __syncthreads();
        const int buf = kt & 1;
        if (kt < qb) issue_tile((kt + 1) * ktmul, buf ^ 1);
        const LAS unsigned char* Kb = L + buf * 65536 + kro;
        const LAS unsigned char* Vb = L + buf * 65536 + 32768 + vro;
        f32x4 sc[4];
        const float negm = -mrun;
#pragma unroll
        for (int j = 0; j < 4; ++j) {
            sc[j] = (f32x4){negm, negm, negm, negm};
#pragma unroll
            for (int ks = 0; ks < 4; ++ks) {
                const bf16x8 a = *(const LAS bf16x8*)(Kb + ((j >> 1) * 32 + (j & 1) * 4) * 256 + (((ks * 4 + q4) ^ fr) << 4));
                sc[j] = mfma16(a, qf[ks], sc[j]);
            }
        }
        if (kt == qb) {
#pragma unroll
            for (int j = 0; j < 4; ++j)
#pragma unroll
                for (int r = 0; r < 4; ++r) if (kt * 64 + (j >> 1) * 32 + q4 * 8 + (j & 1) * 4 + r > qglob) sc[j][r] = -1e30f;
        }
        float tm = -1e30f;
#pragma unroll
        for (int j = 0; j < 4; ++j)
#pragma unroll
            for (int r = 0; r < 4; ++r) tm = fmaxf(tm, sc[j][r]);
        tm = xch16_max(tm); tm = xch32_max(tm);
        if (__builtin_amdgcn_ballot_w64(tm > 6.0f) != 0ull) {
            const float d = fmaxf(tm, 0.f);
            const float alpha = __builtin_amdgcn_exp2f(-d);
            mrun += d;
            lrun *= alpha;
#pragma unroll
            for (int i = 0; i < 16; ++i) O[i] = O[i] * alpha;
#pragma unroll
            for (int j = 0; j < 4; ++j)
#pragma unroll
                for (int r = 0; r < 4; ++r) sc[j][r] -= d;
        }
        float ps = 0.f;
#pragma unroll
        for (int j = 0; j < 4; ++j)
#pragma unroll
            for (int r = 0; r < 4; ++r) { const float pv = __builtin_amdgcn_exp2f(sc[j][r]); sc[j][r] = pv; ps += pv; }
        lrun += ps;
        bf16x8 pf[2];
#pragma unroll
        for (int k2 = 0; k2 < 2; ++k2) {
            u32x4 t; t.x = cvt_pk_bf16(sc[2 * k2][0], sc[2 * k2][1]); t.y = cvt_pk_bf16(sc[2 * k2][2], sc[2 * k2][3]);
            t.z = cvt_pk_bf16(sc[2 * k2 + 1][0], sc[2 * k2 + 1][1]); t.w = cvt_pk_bf16(sc[2 * k2 + 1][2], sc[2 * k2 + 1][3]);
            pf[k2] = as_bf16x8(t);
        }
#pragma unroll
        for (int dvt = 0; dvt < 16; ++dvt)
#pragma unroll
            for (int k2 = 0; k2 < 2; ++k2) {
                const bf16x8 av = *(const LAS bf16x8*)(Vb + dvt * 2048 + (((4 * k2 + q4) ^ vsw) << 4));
                O[dvt] = mfma16(av, pf[k2], O[dvt]);
            }
    }
    lrun = xch16_add(lrun); lrun = xch32_add(lrun);
    const float fac = (m == 0 ? 1.f : lam) / lrun;
    __syncthreads();
    float* Ox = (float*)lds;
    if (m == 1) {
#pragma unroll
        for (int dvt = 0; dvt < 16; ++dvt) *(f32x4*)(Ox + (rt * 16 + fr) * 260 + dvt * 16 + q4 * 4) = O[dvt] * fac;
    }
    __syncthreads();
    if (m == 0) {
        float ss = 0.f;
#pragma unroll
        for (int dvt = 0; dvt < 16; ++dvt) {
            const f32x4 o2 = *(const f32x4*)(Ox + (rt * 16 + fr) * 260 + dvt * 16 + q4 * 4);
            O[dvt] = O[dvt] * fac - o2;
            ss += O[dvt][0] * O[dvt][0] + O[dvt][1] * O[dvt][1] + O[dvt][2] * O[dvt][2] + O[dvt][3] * O[dvt][3];
        }
        ss = xch16_add(ss); ss = xch32_add(ss);
        const float lam_init = 0.8f - 0.6f * expf(-0.3f * (float)l);
        const float rstd = rsqrtf(ss * (1.f / 256.f) + 1e-6f) * (1.f - lam_init);
        const size_t t = (size_t)b * SEQ + qglob;
        u32x2 zr16[16]; f32x4 nw16[16];
#pragma unroll
        for (int dvt = 0; dvt < 16; ++dvt) {
            zr16[dvt] = *(const u32x2*)(p.proj + t * NPROJ + 6656 + h * 256 + dvt * 16 + q4 * 4);
            nw16[dvt] = *(const f32x4*)(p.diff_norm_w + l * 256 + dvt * 16 + q4 * 4);
        }
#pragma unroll
        for (int dvt = 0; dvt < 16; ++dvt) {
            const int dv = dvt * 16 + q4 * 4;
            const f32x4 nw = nw16[dvt];
            const u32x2 zr = zr16[dvt];
            const float z0 = bf_lo(zr.x), z1 = bf_hi(zr.x), z2 = bf_lo(zr.y), z3 = bf_hi(zr.y);
            u32x2 ov;
            ov.x = cvt_pk_bf16(O[dvt][0] * rstd * nw[0] * siluf(z0), O[dvt][1] * rstd * nw[1] * siluf(z1));
            ov.y = cvt_pk_bf16(O[dvt][2] * rstd * nw[2] * siluf(z2), O[dvt][3] * rstd * nw[3] * siluf(z3));
            *(u32x2*)(p.concat + t * DM + 1024 + h * 256 + dv) = ov;
        }
    }
    __syncthreads();
}

DI void phase4(const Params& p, int lc, unsigned char* lds) {
    const int l = lc & 1;
    const int bid = get_bid();
    if (!((PROBE_PHASE == 42 || PROBE_PHASE == 43) && lc >= 2)) {
    if (bid < 32) gdn_chain(p, bid, lds);
    else if (bid < 64) gla_chain(p, bid - 32, lds);
    }
    if (PROBE_PHASE == 41 && lc >= 2) return;
    unsigned* slot = (unsigned*)(lds + LDS_BYTES - 16);
    const int xcd = bid & 7;
    for (;;) {
        __syncthreads();
        if (get_tid() == 0) *slot = atomicAdd(p.cnt + lc * 8 + xcd, 1u);
        __syncthreads();
        const unsigned idx = *slot;
        if (idx >= 64u) break;
        attn_item(p, l, (int)(((idx >> 1) << 4) | (2 * xcd + (idx & 1))), lds, (PROBE_PHASE == 43 && lc >= 2) ? 0 : 1);
    }
}

DI void phase5(const Params& p, int l) {
    const int tid = get_tid();
    const int i16 = tid & 15;
    const int gidx = get_bid() * 32 + (tid >> 4), gstride = gridDim.x * 32;
    const f32x4 nwa0 = *(const f32x4*)(p.gla_norm_w + l * 128 + i16 * 8), nwa1 = *(const f32x4*)(p.gla_norm_w + l * 128 + i16 * 8 + 4);
    const f32x4 nwd0 = *(const f32x4*)(p.gdn_norm_w + l * 128 + i16 * 8), nwd1 = *(const f32x4*)(p.gdn_norm_w + l * 128 + i16 * 8 + 4);
    for (int it0 = gidx; it0 < TT * 8; it0 += 4 * gstride) {
        f32x4 v0[4], v1[4]; u32x4 zr[4];
#pragma unroll
        for (int u = 0; u < 4; ++u) {
            int it = it0 + u * gstride; if (it >= TT * 8) it = it0; const int t = it >> 3, g = (it >> 2) & 1, h = it & 3;
            const float* src = (g ? p.ogdn : p.ogla) + (size_t)t * 512 + h * 128 + i16 * 8;
            v0[u] = *(const f32x4*)src; v1[u] = *(const f32x4*)(src + 4);
            zr[u] = *(const u32x4*)(p.proj + (size_t)t * NPROJ + (g ? 3072 : 1024) + h * 128 + i16 * 8);
        }
#pragma unroll
        for (int u = 0; u < 4; ++u) {
            const int it = it0 + u * gstride; if (it >= TT * 8) break; const int t = it >> 3, g = (it >> 2) & 1, h = it & 3;
            float ss = v0[u][0] * v0[u][0] + v0[u][1] * v0[u][1] + v0[u][2] * v0[u][2] + v0[u][3] * v0[u][3]
                     + v1[u][0] * v1[u][0] + v1[u][1] * v1[u][1] + v1[u][2] * v1[u][2] + v1[u][3] * v1[u][3];
            ss = sum16(ss);
            const float rstd = rsqrtf(ss * (1.f / 128.f) + 1e-6f);
            const f32x4 n0 = g ? nwd0 : nwa0, n1 = g ? nwd1 : nwa1;
            u32x4 o;
            o.x = cvt_pk_bf16(v0[u][0] * rstd * n0[0] * siluf(bf_lo(zr[u].x)), v0[u][1] * rstd * n0[1] * siluf(bf_hi(zr[u].x)));
            o.y = cvt_pk_bf16(v0[u][2] * rstd * n0[2] * siluf(bf_lo(zr[u].y)), v0[u][3] * rstd * n0[3] * siluf(bf_hi(zr[u].y)));
            o.z = cvt_pk_bf16(v1[u][0] * rstd * n1[0] * siluf(bf_lo(zr[u].z)), v1[u][1] * rstd * n1[1] * siluf(bf_hi(zr[u].z)));
            o.w = cvt_pk_bf16(v1[u][2] * rstd * n1[2] * siluf(bf_lo(zr[u].w)), v1[u][3] * rstd * n1[3] * siluf(bf_hi(zr[u].w)));
            *(u32x4*)(p.concat + (size_t)t * DM + g * 512 + h * 128 + i16 * 8) = o;
        }
    }
}

#define XB_TMO      128
#define XB_XCNT(j)  (256  + 64 * (j))
#define XB_XSUB(j)  (1280 + 64 * (j))
#define XB_XGEN(j)  (2304 + 64 * (j))
#define XB_TOP      3328
#define XB_TOPGEN   3392
#define XCD_BAR_WORDS 3456
#define XB_SPIN_CAP (1u << 18)
DI unsigned xb_ld(unsigned* q)              { return __hip_atomic_load(q, __ATOMIC_RELAXED, __HIP_MEMORY_SCOPE_AGENT); }
DI unsigned xb_add(unsigned* q, unsigned v) { return __hip_atomic_fetch_add(q, v, __ATOMIC_RELAXED, __HIP_MEMORY_SCOPE_AGENT); }
DI unsigned xb_xcc_id() { return (unsigned)__builtin_amdgcn_s_getreg((3 << 11) | 20) & 0xFu; }
#define XB_SPIN(cond, bar) do { unsigned _sp = 0; while (cond) { __builtin_amdgcn_s_sleep(1); \
    if ((++_sp & 255u) == 0u) { if (xb_ld(&(bar)[XB_TMO])) break; if (_sp > XB_SPIN_CAP) { atomicAdd(&(bar)[XB_TMO], 1u); break; } } } } while (0)
struct XcdBarrier { unsigned* bar; unsigned x; volatile LAS unsigned* st; };
DI XcdBarrier xcd_barrier_post(unsigned* bar, volatile LAS unsigned* st) {
    XcdBarrier b; b.bar = bar; b.x = xb_xcc_id(); b.st = st;
    if (threadIdx.x == 0) (void)xb_add(&bar[XB_XCNT(b.x)], 1u);
    return b;
}
DI void xcd_barrier_complete(unsigned* bar, unsigned x, unsigned& nloc, unsigned& nx) {
    const unsigned G = gridDim.x * gridDim.y * gridDim.z;
    unsigned sum, cnt, mine, sp = 0u;
    for (;;) {
        sum = 0u; cnt = 0u; mine = 0u;
#pragma unroll
        for (unsigned j = 0; j < 16; ++j) { const unsigned c = xb_ld(&bar[XB_XCNT(j)]); sum += c; cnt += (c > 0u) ? 1u : 0u; mine = (j == x) ? c : mine; }
        if (sum == G) break;
        __builtin_amdgcn_s_sleep(1);
        if ((++sp & 255u) == 0u) { if (xb_ld(&bar[XB_TMO])) break; if (sp > XB_SPIN_CAP) { atomicAdd(&bar[XB_TMO], 1u); break; } }
    }
    nloc = mine > 0u ? mine : 1u; nx = cnt > 0u ? cnt : 1u;
}
DI void xcd_barrier(const XcdBarrier& b) {
    asm volatile("s_waitcnt vmcnt(0)" ::: "memory");
    __syncthreads();
    if (threadIdx.x == 0) {
        unsigned* bar = b.bar;
        __builtin_amdgcn_s_waitcnt(0);
        unsigned nloc = b.st[0], nx = b.st[1];
        if (nloc == 0u) { xcd_barrier_complete(bar, b.x, nloc, nx); b.st[0] = nloc; b.st[1] = nx; }
        const unsigned old = xb_add(&bar[XB_XSUB(b.x)], 1u);
        const unsigned gen = old / nloc;
        if (old + 1u == (gen + 1u) * nloc) {
            __builtin_amdgcn_fence(__ATOMIC_RELEASE, "agent");
            asm volatile("s_waitcnt vmcnt(0)" ::: "memory");
            const unsigned og = xb_add(&bar[XB_TOP], 1u);
            const unsigned tg = og / nx;
            if (og + 1u == (tg + 1u) * nx) xb_add(&bar[XB_TOPGEN], 1u);
            else XB_SPIN(xb_ld(&bar[XB_TOPGEN]) == tg, bar);
            __builtin_amdgcn_fence(__ATOMIC_ACQUIRE, "agent");
            xb_add(&bar[XB_XGEN(b.x)], 1u);
            asm volatile("s_waitcnt vmcnt(0)" ::: "memory");
        } else {
            XB_SPIN(xb_ld(&bar[XB_XGEN(b.x)]) == gen, bar);
            __builtin_amdgcn_fence(__ATOMIC_ACQUIRE, "agent");
            asm volatile("s_waitcnt vmcnt(0)" ::: "memory");
        }
    }
    __syncthreads();
}

__global__ void __launch_bounds__(512, 2) fwd_megakernel(Params p_unused) {
    extern __shared__ __attribute__((aligned(16))) unsigned char shm[];
    cg::grid_group grid = cg::this_grid();
    volatile LAS unsigned* xst = (volatile LAS unsigned*)((LAS unsigned char*)shm + (LDS_BYTES - 32));
    if (threadIdx.x < 2) xst[threadIdx.x] = 0u;
    __syncthreads();
    XcdBarrier xb;
    { const Params p = load_params(); xb = xcd_barrier_post(p.bar, xst); }
    { const Params p = load_params(); phase0(p, (float*)shm); }
    grid.sync();
#if PROBE_PHASE == 10
    { const Params p = load_params(); phase0(p, (float*)shm); }
    xcd_barrier(xb);
#endif
#pragma unroll 1
    for (int l = 0; l < 2; ++l) {
#pragma unroll 1
        for (int rep = 0; rep < (PROBE_PHASE == 1 ? 2 : 1); ++rep) {
        { const Params p = load_params(); phase1(p, l, l == 0 ? p.x : p.x1); }
        xcd_barrier(xb);
        }
#pragma unroll 1
        for (int rep = 0; rep < (PROBE_PHASE == 2 ? 2 : 1); ++rep) {
            const Params p = load_params();
            pg8::StaticOrder S; S.init(TT, NPAD, (int)gridDim.x, get_bid());
            pg8::Gemm g{p.hbuf, p.WinT + (size_t)l * NPAD * 2048, TT, NPAD, 2048};
            EpiProj E{p.proj, p.small};
            pg8::gemm_phase<EpiProj>((LAS unsigned char*)shm, g, S, E);
            xcd_barrier(xb);
        }
#pragma unroll 1
        for (int rep = 0; rep < ((PROBE_PHASE == 3 || (PROBE_PHASE >= 31 && PROBE_PHASE <= 36)) ? 2 : 1); ++rep) {
        { const Params p = load_params(); phase3(p, l, shm, (rep == 0 || PROBE_PHASE == 3) ? 7 : (PROBE_PHASE == 32 ? 2 : (PROBE_PHASE == 33 ? 4 : 1)), (rep == 1 && PROBE_PHASE >= 34) ? PROBE_PHASE - 33 : 0); }
        xcd_barrier(xb);
        }
#pragma unroll 1
        for (int rep = 0; rep < ((PROBE_PHASE == 4 || PROBE_PHASE == 41 || PROBE_PHASE == 42 || PROBE_PHASE == 43) ? 2 : 1); ++rep) {
        { Params p = load_params(); if (PROBE_PHASE == 43 && rep == 1) p.concat = p.hbuf; phase4(p, l + 2 * rep, shm); }
        xcd_barrier(xb);
        }
#pragma unroll 1
        for (int rep = 0; rep < (PROBE_PHASE == 5 ? 2 : 1); ++rep) {
        { const Params p = load_params(); phase5(p, l); }
        xcd_barrier(xb);
        }
#pragma unroll 1
        for (int rep = 0; rep < (PROBE_PHASE == 6 ? 2 : 1); ++rep) {
            const Params p = load_params();
            pg8::StaticOrder S; S.init(TT, DM, (int)gridDim.x, get_bid());
            pg8::Gemm g{p.concat, p.WoutT + (size_t)l * 2048 * 2048, TT, DM, 2048};
            EpiOut E{l == 0 ? p.x : p.x1, l == 0 ? p.x1 : p.out, p.mod + (size_t)l * 4 * 6144 + 4096};
            pg8::gemm_phase<EpiOut>((LAS unsigned char*)shm, g, S, E);
            xcd_barrier(xb);
        }
    }
}

#ifdef MULTI_LAUNCH
__global__ void __launch_bounds__(512, 2) k_p0(Params p) { extern __shared__ __attribute__((aligned(16))) unsigned char shm[]; phase0(p, (float*)shm); }
__global__ void __launch_bounds__(512, 2) k_p1(Params p, int l) { phase1(p, l, l == 0 ? p.x : p.x1); }
__global__ void __launch_bounds__(512, 2) k_p2(Params p, int l) { extern __shared__ __attribute__((aligned(16))) unsigned char shm[];
    pg8::StaticOrder S; S.init(TT, NPAD, (int)gridDim.x, (int)blockIdx.x);
    pg8::Gemm g{p.hbuf, p.WinT + (size_t)l * NPAD * 2048, TT, NPAD, 2048};
    EpiProj E{p.proj, p.small};
    pg8::gemm_phase<EpiProj>((LAS unsigned char*)shm, g, S, E); }
__global__ void __launch_bounds__(512, 2) k_p3a(Params p, int l) { extern __shared__ __attribute__((aligned(16))) unsigned char shm[]; for (int it = blockIdx.x; it < 512; it += gridDim.x) gdn_prep(p, l, it, shm); }
__global__ void __launch_bounds__(512, 2) k_p3b(Params p, int l) { extern __shared__ __attribute__((aligned(16))) unsigned char shm[]; for (int it = blockIdx.x; it < 128; it += gridDim.x) gla_prep(p, l, it, shm); }
__global__ void __launch_bounds__(512, 2) k_p3c(Params p, int l) { extern __shared__ __attribute__((aligned(16))) unsigned char shm[]; for (int it = blockIdx.x; it < 128; it += gridDim.x) diff_prep(p, l, it, shm); }
__global__ void __launch_bounds__(512, 2) k_p4a(Params p, int l) { extern __shared__ __attribute__((aligned(16))) unsigned char shm[]; gdn_chain(p, blockIdx.x, shm); }
__global__ void __launch_bounds__(512, 2) k_p4b(Params p, int l) { extern __shared__ __attribute__((aligned(16))) unsigned char shm[]; gla_chain(p, blockIdx.x, shm); }
__global__ void __launch_bounds__(512, 2) k_p4c(Params p, int l) { extern __shared__ __attribute__((aligned(16))) unsigned char shm[]; attn_item(p, l, blockIdx.x, shm); }
__global__ void __launch_bounds__(512, 2) k_p5(Params p, int l) { phase5(p, l); }
__global__ void __launch_bounds__(512, 2) k_p6(Params p, int l) { extern __shared__ __attribute__((aligned(16))) unsigned char shm[];
    pg8::StaticOrder S; S.init(TT, DM, (int)gridDim.x, (int)blockIdx.x);
    pg8::Gemm g{p.concat, p.WoutT + (size_t)l * 2048 * 2048, TT, DM, 2048};
    EpiOut E{l == 0 ? p.x : p.x1, l == 0 ? p.x1 : p.out, p.mod + (size_t)l * 4 * 6144 + 4096};
    pg8::gemm_phase<EpiOut>((LAS unsigned char*)shm, g, S, E); }
#endif

extern "C" void kernel_launch(void* const* d_in, const int* in_sizes, int n_in, void* d_out, int out_size, void* d_ws, size_t ws_size, hipStream_t stream) {
    static int grid_blocks = 0;
    if (!grid_blocks) {
        int dev = 0, cus = 0, per_cu = 0;
        hipGetDevice(&dev);
        hipDeviceGetAttribute(&cus, hipDeviceAttributeMultiprocessorCount, dev);
        hipFuncSetAttribute((const void*)fwd_megakernel, hipFuncAttributeMaxDynamicSharedMemorySize, LDS_BYTES);
        hipOccupancyMaxActiveBlocksPerMultiprocessor(&per_cu, fwd_megakernel, 512, LDS_BYTES);
        if (per_cu < 1) per_cu = 1;
        if (per_cu > 1) per_cu = 1;
        grid_blocks = cus * per_cu;
    }
    Params p{};
    p.x = (const float*)d_in[0]; p.c = (const float*)d_in[1]; p.pos = (const int*)d_in[2];
    p.norm_w = (const float*)d_in[3]; p.w_ada = (const float*)d_in[4]; p.b_ada = (const float*)d_in[5]; p.w_in = (const float*)d_in[6];
    p.gla_w_lr = (const float*)d_in[7]; p.gla_b_lr = (const float*)d_in[8]; p.gla_norm_w = (const float*)d_in[9];
    p.gdn_conv_w = (const float*)d_in[10]; p.gdn_a_log = (const float*)d_in[11]; p.gdn_dt_bias = (const float*)d_in[12]; p.gdn_norm_w = (const float*)d_in[13];
    p.diff_q_norm_w = (const float*)d_in[14]; p.diff_k_norm_w = (const float*)d_in[15]; p.diff_lambda = (const float*)d_in[16]; p.diff_norm_w = (const float*)d_in[17];
    p.w_out = (const float*)d_in[18];
    p.out = (float*)d_out;
    char* ws = (char*)d_ws; size_t off = 0;
    auto take = [&](size_t bytes) { char* r = ws + off; off += (bytes + 255) & ~(size_t)255; return r; };
    p.WinT = (bf16_t*)take((size_t)2 * NPAD * 2048 * 2);
    p.WoutT = (bf16_t*)take((size_t)2 * 2048 * 2048 * 2);
    p.mod = (float*)take((size_t)2 * 4 * 6144 * 4);
    p.rope = (float*)take((size_t)TT * 128 * 4);
    p.lam = (float*)take(256);
    p.cnt = (unsigned*)take(256);
    p.bar = (unsigned*)take((size_t)XCD_BAR_WORDS * 4);
    p.hbuf = (bf16_t*)take((size_t)TT * DM * 2);
    p.proj = (bf16_t*)take((size_t)TT * NPROJ * 2);
    p.small = (float*)take((size_t)TT * 32 * 4);
    p.x1 = (float*)d_out;
    p.concat = (bf16_t*)take((size_t)TT * DM * 2);
    p.gqe = (bf16_t*)take((size_t)512 * 4096 * 2);
    p.gatt = (bf16_t*)take((size_t)512 * 4096 * 2);
    p.gkdT = (bf16_t*)take((size_t)512 * 4096 * 2);
    p.gvT = (bf16_t*)take((size_t)512 * 8192 * 2);
    p.gdec = (float*)take((size_t)512 * 64 * 4);
    p.ogla = (float*)p.hbuf;
    p.du = (float*)take((size_t)512 * 8192 * 4);
    p.dw = (bf16_t*)take((size_t)512 * 8192 * 2);
    p.dqe = (bf16_t*)take((size_t)512 * 8192 * 2);
    p.dktT = (bf16_t*)take((size_t)512 * 8192 * 2);
    p.dqk = (bf16_t*)take((size_t)512 * 4096 * 2);
    p.dcd = (float*)take((size_t)512 * 4);
    p.ogdn = (float*)p.hbuf + (size_t)TT * 512;
    p.qd = (bf16_t*)take((size_t)32 * SEQ * 128 * 2);
    p.kd = (bf16_t*)take((size_t)32 * SEQ * 128 * 2);
    p.vT = (bf16_t*)take((size_t)16 * 256 * SEQ * 2);
    if (off > ws_size) { fprintf(stderr, "workspace too small: need %zu have %zu\n", off, ws_size); return; }
    (void)hipMemsetAsync(p.bar, 0, (size_t)XCD_BAR_WORDS * 4, stream);
    void* args[] = {&p};
    hipError_t e = hipLaunchCooperativeKernel((void*)fwd_megakernel, dim3(grid_blocks), dim3(512), args, LDS_BYTES, stream);
    if (e != hipSuccess) fprintf(stderr, "cooperative launch failed: %s (grid %d)\n", hipGetErrorString(e), grid_blocks);
}
```

```cpp
#include <hip/hip_runtime.h>
#include <hip/hip_cooperative_groups.h>
#include <cstdio>
namespace cg = cooperative_groups;

#define DI __device__ __forceinline__
#define LAS __attribute__((address_space(3)))
typedef unsigned short bf16_t;
typedef short bf16x8 __attribute__((ext_vector_type(8)));
typedef float f32x4 __attribute__((ext_vector_type(4)));
typedef float f32x2 __attribute__((ext_vector_type(2)));
typedef unsigned u32x4 __attribute__((ext_vector_type(4)));
typedef unsigned u32x2 __attribute__((ext_vector_type(2)));

constexpr int TT = 8192, DM = 2048, SEQ = 2048, DIN = 7704, NPROJ = 7680, NPAD = 7936;
constexpr int LDS_BYTES = 160 * 1024;
#ifndef PROBE_PHASE
#define PROBE_PHASE 0
#endif

struct Params {
    const float *x, *c; const int* pos;
    const float *norm_w, *w_ada, *b_ada, *w_in, *gla_w_lr, *gla_b_lr, *gla_norm_w, *gdn_conv_w, *gdn_a_log, *gdn_dt_bias,
        *gdn_norm_w, *diff_q_norm_w, *diff_k_norm_w, *diff_lambda, *diff_norm_w, *w_out;
    float* out;
    bf16_t *WinT, *WoutT, *hbuf, *proj, *concat;
    float *mod, *rope, *lam, *small, *x1;
    unsigned* cnt; unsigned* bar;
    bf16_t *gqe, *gatt, *gkdT, *gvT; float *gdec, *ogla;
    float *du; bf16_t *dw, *dqe, *dktT, *dqk; float *dcd, *ogdn;
    bf16_t *qd, *kd, *vT;
};

typedef const __attribute__((address_space(4))) unsigned char* KP4;
DI int get_tid() { int t = threadIdx.x; asm volatile("" : "+v"(t)); return t; }
DI int get_bid() { int b = blockIdx.x; asm volatile("" : "+s"(b)); return b; }
DI Params load_params() { KP4 q = (KP4)__builtin_amdgcn_kernarg_segment_ptr(); asm volatile("" : "+s"(q)); Params r; __builtin_memcpy(&r, q, sizeof(Params)); return r; }
typedef __bf16 bf16x2_t __attribute__((ext_vector_type(2)));
DI unsigned cvt_pk_bf16(float lo, float hi) { const f32x2 v = {lo, hi}; const bf16x2_t r = __builtin_convertvector(v, bf16x2_t); return __builtin_bit_cast(unsigned, r); }
DI float bf_lo(unsigned u) { return __uint_as_float(u << 16); }
DI float bf_hi(unsigned u) { return __uint_as_float(u & 0xffff0000u); }
DI float bf2f(bf16_t v) { return __uint_as_float(((unsigned)v) << 16); }
DI float siluf(float x) { return x / (1.f + __expf(-x)); }
DI float xch16_max(float x) { const unsigned u = __float_as_uint(x); const u32x2 r = __builtin_amdgcn_permlane16_swap(u, u, false, false); return fmaxf(__uint_as_float(r[0]), __uint_as_float(r[1])); }
DI float xch32_max(float x) { const unsigned u = __float_as_uint(x); const u32x2 r = __builtin_amdgcn_permlane32_swap(u, u, false, false); return fmaxf(__uint_as_float(r[0]), __uint_as_float(r[1])); }
DI float xch16_add(float x) { const unsigned u = __float_as_uint(x); const u32x2 r = __builtin_amdgcn_permlane16_swap(u, u, false, false); return __uint_as_float(r[0]) + __uint_as_float(r[1]); }
DI float xch32_add(float x) { const unsigned u = __float_as_uint(x); const u32x2 r = __builtin_amdgcn_permlane32_swap(u, u, false, false); return __uint_as_float(r[0]) + __uint_as_float(r[1]); }
template <int CTRL> DI float dpp_f(float x) { return __int_as_float(__builtin_amdgcn_update_dpp(0, __float_as_int(x), CTRL, 0xf, 0xf, false)); }
DI float sum4(float x) { x += dpp_f<0xB1>(x); x += dpp_f<0x4E>(x); return x; }
DI float sum16(float x) { x = sum4(x); x += dpp_f<0x141>(x); x += dpp_f<0x140>(x); return x; }
DI f32x4 mfma16(bf16x8 a, bf16x8 b, f32x4 c) { return __builtin_amdgcn_mfma_f32_16x16x32_bf16(a, b, c, 0, 0, 0); }
DI bf16x8 as_bf16x8(u32x4 v) { return __builtin_bit_cast(bf16x8, v); }

namespace pg8 {
constexpr int BM = 256, BK = 64, HALF = 128, HTB = HALF * BK * 2, STAGE_BYTES = 8 * HTB, NXCD = 8, WGM = 8;
DI int lds_byte(int r, int c) { const int st = (r >> 4) * 2 + (c >> 5), rr = r & 15, cc = c & 31, ob = rr * 64 + cc * 2; return st * 1024 + (ob ^ (((ob >> 9) & 1) << 5)); }
DI void stage_rc(int b, int& R, int& C) { const int st = b / 1024, sb = b % 1024, swz = sb ^ (((sb >> 9) & 1) << 5); R = (st >> 1) * 16 + swz / 64; C = (st & 1) * 32 + (swz % 64) / 2; }
DI int perm32(int rho) { const int n = rho >> 4, i = rho & 15; return 8 * (i >> 2) + 4 * n + (i & 3); }
struct Unit { int pm, pn; };
struct Gemm { const bf16_t* A; const bf16_t* Bt; int M, N, K; };
struct StaticOrder {
    int nM, nN, nwg, G, c;
    DI void init(int M, int N, int G_, int c_) { nM = M / BM; nN = N / BM; nwg = nM * nN; G = G_; c = c_; }
    DI bool next(int i, Unit& u) const {
        const long L = (long)i * G + c; if (L >= nwg) return false;
        int wgid = (int)L; { const int q = nwg / NXCD, r = nwg % NXCD, xcd = wgid % NXCD, off = wgid / NXCD; wgid = (xcd < r ? xcd * (q + 1) : r * (q + 1) + (xcd - r) * q) + off; }
        const int nig = WGM * nN, gid = wgid / nig, fm = gid * WGM, gsz = (nM - fm) < WGM ? (nM - fm) : WGM;
        u.pm = fm + ((wgid % nig) % gsz); u.pn = (wgid % nig) / gsz; return true;
    }
};

template <class Epi>
DI void gemm_phase(LAS unsigned char* lds, const Gemm g, const StaticOrder& S, const Epi& E) {
    const int tid = get_tid(), wid = __builtin_amdgcn_readfirstlane(tid >> 6), lane = tid & 63, wr = wid >> 2, wc = wid & 3, fr = lane & 15, fq = lane >> 4;
    const int K = g.K, nt = K / BK;
    unsigned voffA[2], voffB[2];
#pragma unroll
    for (int i = 0; i < 2; ++i) { int R, C; stage_rc(tid * 16 + i * 8192, R, C); const int Rb = Epi::PERM ? ((R & ~31) + perm32(R & 31)) : R;
        voffA[i] = (unsigned)(R * K + C) * 2u; voffB[i] = (unsigned)(Rb * K + C) * 2u; }
    const size_t kstep = (size_t)(BK * 2);
    const size_t hstep = (size_t)HALF * K * 2;
    const size_t tstep = 2 * hstep;
    const unsigned ldsw = (unsigned)wid * 1024u;
    const int aoff = lds_byte(wr * 64 + fr, fq * 8), boff = lds_byte(wc * 32 + fr, fq * 8);
#define PG8_SA(b, h) (((b) * 2 + (h)) * HTB)
#define PG8_SB(b, h) ((4 + (b) * 2 + (h)) * HTB)
#define PG8_STAGE(bufoff, gbase, voff) do { _Pragma("unroll") for (int _i = 0; _i < 2; ++_i) \
        __builtin_amdgcn_global_load_lds((const unsigned*)((const char*)(gbase) + (voff)[_i]), (LAS unsigned*)(lds + (bufoff) + ldsw + _i * 8192), 16, 0, 0); } while (0)
#define PG8_LDA(dst, b, h) do { _Pragma("unroll") for (int m = 0; m < 4; ++m) _Pragma("unroll") for (int k = 0; k < 2; ++k) dst[m][k] = *(const LAS bf16x8*)(lds + PG8_SA(b, h) + aoff + m * 2048 + k * 1024); } while (0)
#define PG8_LDB(dst, b, h) do { _Pragma("unroll") for (int n = 0; n < 2; ++n) _Pragma("unroll") for (int k = 0; k < 2; ++k) dst[n][k] = *(const LAS bf16x8*)(lds + PG8_SB(b, h) + boff + n * 2048 + k * 1024); } while (0)
#define PG8_MMA(ai, bj, At, Bt) do { __builtin_amdgcn_s_setprio(1); _Pragma("unroll") for (int m = 0; m < 4; ++m) _Pragma("unroll") for (int n = 0; n < 2; ++n) _Pragma("unroll") for (int k = 0; k < 2; ++k) \
        acc[ai][bj][m][n] = __builtin_amdgcn_mfma_f32_16x16x32_bf16(Bt[n][k], At[m][k], acc[ai][bj][m][n], 0, 0, 0); __builtin_amdgcn_s_setprio(0); } while (0)
#define PG8_WAIT_V(n) asm volatile("s_waitcnt vmcnt(" #n ")" ::: "memory")
#define PG8_WAIT_L(n) asm volatile("s_waitcnt lgkmcnt(" #n ")" ::: "memory")
#define PG8_BAR __builtin_amdgcn_s_barrier()
#define PG8_SCHED __builtin_amdgcn_sched_barrier(0)
    Unit cur, nxt; int ui = 0;
    if (!S.next(0, cur)) return;
    f32x4 acc[2][2][4][2];
#pragma unroll
    for (int a = 0; a < 2; ++a)
#pragma unroll
        for (int b = 0; b < 2; ++b)
#pragma unroll
            for (int m = 0; m < 4; ++m)
#pragma unroll
                for (int n = 0; n < 2; ++n) acc[a][b][m][n] = (f32x4){0.f, 0.f, 0.f, 0.f};
    bf16x8 At[4][2], B0[2][2], B1[2][2];
    const char* cA = (const char*)g.A + (size_t)cur.pm * tstep; const char* cB = (const char*)g.Bt + (size_t)cur.pn * tstep;
    PG8_STAGE(PG8_SB(0, 0), cB, voffB); PG8_STAGE(PG8_SA(0, 0), cA, voffA); PG8_STAGE(PG8_SB(0, 1), cB + hstep, voffB); PG8_STAGE(PG8_SA(0, 1), cA + hstep, voffA);
    if (wr == 1) PG8_BAR;
    PG8_WAIT_V(4); PG8_BAR;
    PG8_STAGE(PG8_SB(1, 0), cB + kstep, voffB); PG8_STAGE(PG8_SA(1, 0), cA + kstep, voffA); PG8_STAGE(PG8_SB(1, 1), cB + hstep + kstep, voffB);
    PG8_WAIT_V(6); PG8_BAR;
    for (;;) {
        const bool has_next = S.next(ui + 1, nxt);
        const char* nA = has_next ? (const char*)g.A + (size_t)nxt.pm * tstep : cA; const char* nB = has_next ? (const char*)g.Bt + (size_t)nxt.pn * tstep : cB;
        for (int t = 0; t < nt; t += 2) {
            const bool last = (t == nt - 2);
            const char* a1 = cA + (size_t)(t + 1) * kstep;
            const char* a2 = last ? nA : cA + (size_t)(t + 2) * kstep; const char* b2 = last ? nB : cB + (size_t)(t + 2) * kstep;
            const char* a3 = a2 + kstep; const char* b3 = b2 + kstep;
            PG8_LDB(B0, 0, 0); PG8_SCHED; PG8_LDA(At, 0, 0); PG8_STAGE(PG8_SA(1, 1), a1 + hstep, voffA);
            PG8_WAIT_L(8); PG8_BAR; PG8_WAIT_L(0); PG8_MMA(0, 0, At, B0); PG8_BAR; PG8_SCHED;
            PG8_LDB(B1, 0, 1); PG8_STAGE(PG8_SB(0, 0), b2, voffB);
            PG8_BAR; PG8_WAIT_L(0); PG8_MMA(0, 1, At, B1); PG8_BAR;
            PG8_LDA(At, 0, 1); PG8_STAGE(PG8_SA(0, 0), a2, voffA);
            PG8_BAR; PG8_WAIT_L(0); PG8_MMA(1, 0, At, B0); PG8_BAR; PG8_SCHED;
            PG8_STAGE(PG8_SB(0, 1), b2 + hstep, voffB);
            PG8_WAIT_V(6); PG8_BAR; PG8_MMA(1, 1, At, B1); PG8_BAR;
            PG8_LDB(B0, 1, 0); PG8_SCHED; PG8_LDA(At, 1, 0); PG8_STAGE(PG8_SA(0, 1), a2 + hstep, voffA);
            PG8_WAIT_L(8); PG8_BAR; PG8_WAIT_L(0); PG8_MMA(0, 0, At, B0); PG8_BAR; PG8_SCHED;
            PG8_LDB(B1, 1, 1); PG8_STAGE(PG8_SB(1, 0), b3, voffB);
            PG8_BAR; PG8_WAIT_L(0); PG8_MMA(0, 1, At, B1); PG8_BAR;
            PG8_LDA(At, 1, 1); PG8_STAGE(PG8_SA(1, 0), a3, voffA);
            PG8_BAR; PG8_WAIT_L(0); PG8_MMA(1, 0, At, B0); PG8_BAR; PG8_SCHED;
            PG8_STAGE(PG8_SB(1, 1), b3 + hstep, voffB);
            PG8_WAIT_V(6); PG8_BAR; PG8_MMA(1, 1, At, B1); PG8_BAR;
        }
        E(acc, cur, wr, wc, fr, fq);
        if (!has_next) break;
#pragma unroll
        for (int a = 0; a < 2; ++a)
#pragma unroll
            for (int b = 0; b < 2; ++b)
#pragma unroll
                for (int m = 0; m < 4; ++m)
#pragma unroll
                    for (int n = 0; n < 2; ++n) acc[a][b][m][n] = (f32x4){0.f, 0.f, 0.f, 0.f};
        cur = nxt; cA = nA; cB = nB; ++ui;
    }
    PG8_WAIT_V(0);
    if (wr == 0) PG8_BAR;
    PG8_BAR;
#undef PG8_SA
#undef PG8_SB
#undef PG8_STAGE
#undef PG8_LDA
#undef PG8_LDB
#undef PG8_MMA
#undef PG8_WAIT_V
#undef PG8_WAIT_L
#undef PG8_BAR
#undef PG8_SCHED
}
}

struct EpiProj {
    static constexpr bool PERM = true;
    bf16_t* proj; float* small;
    DI void operator()(const f32x4 (&acc)[2][2][4][2], const pg8::Unit& u, int wr, int wc, int fr, int fq) const {
        const int row0 = u.pm * 256 + wr * 64 + fr;
        if (u.pn < 30) {
            const int col0 = u.pn * 256 + wc * 32 + 8 * fq;
#pragma unroll
            for (int ai = 0; ai < 2; ++ai)
#pragma unroll
                for (int m = 0; m < 4; ++m) {
                    bf16_t* rowp = proj + (size_t)(row0 + ai * 128 + m * 16) * NPROJ + col0;
#pragma unroll
                    for (int bj = 0; bj < 2; ++bj) {
                        const f32x4 v0 = acc[ai][bj][m][0], v1 = acc[ai][bj][m][1];
                        u32x4 w; w.x = cvt_pk_bf16(v0[0], v0[1]); w.y = cvt_pk_bf16(v0[2], v0[3]); w.z = cvt_pk_bf16(v1[0], v1[1]); w.w = cvt_pk_bf16(v1[2], v1[3]);
                        *(u32x4*)(rowp + bj * 128) = w;
                    }
                }
        } else if (wc == 0) {
#pragma unroll
            for (int ai = 0; ai < 2; ++ai)
#pragma unroll
                for (int m = 0; m < 4; ++m) {
                    float* rowp = small + (size_t)(row0 + ai * 128 + m * 16) * 32 + 8 * fq;
                    *(f32x4*)(rowp) = acc[ai][0][m][0]; *(f32x4*)(rowp + 4) = acc[ai][0][m][1];
                }
        }
    }
};
struct EpiOut {
    static constexpr bool PERM = false;
    const float* xin; float* xout; const float* gate;
    DI void operator()(const f32x4 (&acc)[2][2][4][2], const pg8::Unit& u, int wr, int wc, int fr, int fq) const {
        const int row0 = u.pm * 256 + wr * 64 + fr, col0 = u.pn * 256 + wc * 32 + 4 * fq;
        const int b = (u.pm * 256) >> 11;
        f32x4 g[2][2];
#pragma unroll
        for (int bj = 0; bj < 2; ++bj)
#pragma unroll
            for (int n = 0; n < 2; ++n) g[bj][n] = *(const f32x4*)(gate + b * 6144 + col0 + bj * 128 + n * 16);
#pragma unroll
        for (int ai = 0; ai < 2; ++ai)
#pragma unroll
            for (int mh = 0; mh < 2; ++mh) {
                f32x4 xv[2][2][2];
#pragma unroll
                for (int mm = 0; mm < 2; ++mm)
#pragma unroll
                    for (int bj = 0; bj < 2; ++bj)
#pragma unroll
                        for (int n = 0; n < 2; ++n)
                            xv[mm][bj][n] = *(const f32x4*)(xin + (size_t)(row0 + ai * 128 + (2 * mh + mm) * 16) * DM + col0 + bj * 128 + n * 16);
#pragma unroll
                for (int mm = 0; mm < 2; ++mm)
#pragma unroll
                    for (int bj = 0; bj < 2; ++bj)
#pragma unroll
                        for (int n = 0; n < 2; ++n)
                            *(f32x4*)(xout + (size_t)(row0 + ai * 128 + (2 * mh + mm) * 16) * DM + col0 + bj * 128 + n * 16) = xv[mm][bj][n] + g[bj][n] * acc[ai][bj][2 * mh + mm][n];
            }
    }
};

DI int orig_col(int j) {
    if (j < 1024) return j;
    if (j < 3072) return j + 16;
    if (j < 7680) return j + 24;
    if (j < 7696) return 1024 + (j - 7680);
    if (j < 7704) return 3088 + (j - 7696);
    return -1;
}
DI void transpose_tile(const float* src, int ldsrc, bf16_t* dst, int n0, int k0, bool remap, float* tile) {
    const int tid = get_tid(), nn = tid & 63, kb = tid >> 6;
    const int n = n0 + nn, oc = remap ? orig_col(n) : n;
    float v[32];
#pragma unroll
    for (int i = 0; i < 32; ++i) v[i] = oc >= 0 ? __builtin_nontemporal_load(src + (size_t)(k0 + kb + 8 * i) * ldsrc + oc) : 0.f;
#pragma unroll
    for (int i = 0; i < 32; ++i) tile[(kb + 8 * i) * 65 + nn] = v[i];
    __syncthreads();
    const int r = tid >> 3, seg = tid & 7;
#pragma unroll
    for (int half = 0; half < 2; ++half) {
        unsigned pk[8];
#pragma unroll
        for (int j = 0; j < 8; ++j) pk[j] = cvt_pk_bf16(tile[(half * 128 + seg * 16 + 2 * j) * 65 + r], tile[(half * 128 + seg * 16 + 2 * j + 1) * 65 + r]);
        u32x4* d = (u32x4*)(dst + (size_t)(n0 + r) * 2048 + k0 + half * 128 + seg * 16);
        d[0] = (u32x4){pk[0], pk[1], pk[2], pk[3]}; d[1] = (u32x4){pk[4], pk[5], pk[6], pk[7]};
    }
    __syncthreads();
}
DI void adaln_item(const Params& p, int l, int cgp, float* lds) {
    const int tid = get_tid(), w = tid >> 6, lane = tid & 63;
    for (int i = tid; i < 8192; i += 512) { const float cv = p.c[i]; lds[i] = cv / (1.f + expf(-cv)); }
    __syncthreads();
    const int col = cgp * 64 + lane;
    const float* wp = p.w_ada + (size_t)l * 2048 * 6144 + col;
    float a0 = 0.f, a1 = 0.f, a2 = 0.f, a3 = 0.f;
    for (int k = w * 256; k < w * 256 + 256; k += 64) {
        float wv[64];
#pragma unroll
        for (int j = 0; j < 64; ++j) wv[j] = __builtin_nontemporal_load(wp + (size_t)(k + j) * 6144);
#pragma unroll
        for (int j = 0; j < 64; ++j) { a0 += lds[k + j] * wv[j]; a1 += lds[2048 + k + j] * wv[j]; a2 += lds[4096 + k + j] * wv[j]; a3 += lds[6144 + k + j] * wv[j]; }
    }
    float* red = lds + 8192;
    red[(w * 4 + 0) * 64 + lane] = a0; red[(w * 4 + 1) * 64 + lane] = a1; red[(w * 4 + 2) * 64 + lane] = a2; red[(w * 4 + 3) * 64 + lane] = a3;
    __syncthreads();
    if (tid < 256) {
        const int b = tid >> 6; float s = 0.f;
#pragma unroll
        for (int ww = 0; ww < 8; ++ww) s += red[(ww * 4 + b) * 64 + lane];
        p.mod[(size_t)(l * 4 + b) * 6144 + col] = s + p.b_ada[l * 6144 + col];
    }
    __syncthreads();
}
DI void phase0(const Params& p, float* lds) {
    const int tid = get_tid();
    const int bid = get_bid();
    if (bid == 0 && tid < 64) p.cnt[tid] = 0u;
    if (bid == 1 && tid < 2) {
        const float* lv = p.diff_lambda + tid * 512; float s1 = 0.f, s2 = 0.f;
        for (int i = 0; i < 128; ++i) { s1 += lv[i] * lv[128 + i]; s2 += lv[256 + i] * lv[384 + i]; }
        const float lam_init = 0.8f - 0.6f * expf(-0.3f * (float)tid);
        p.lam[tid] = expf(s1) - expf(s2) + lam_init;
    }
    constexpr int N_ADA = 192, N_ROPE = 128, N_WIN = 124 * 8, N_WOUT = 32 * 8;
    constexpr int N_ITEMS = N_ADA + N_ROPE + 2 * (N_WIN + N_WOUT);
    for (int it = bid; it < N_ITEMS; it += gridDim.x) {
        if (it < N_ADA) { adaln_item(p, it / 96, it % 96, lds); }
        else if (it < N_ADA + N_ROPE) {
            const int t0 = (it - N_ADA) * 64;
            for (int e = tid; e < 64 * 64; e += 512) {
                const int t = t0 + (e >> 6), i = e & 63;
                const float inv = powf(10000.0f, -(float)i / 64.0f);
                const float ang = (float)p.pos[t] * inv;
                p.rope[(size_t)t * 128 + i] = cosf(ang); p.rope[(size_t)t * 128 + 64 + i] = sinf(ang);
            }
        } else {
            int j = it - N_ADA - N_ROPE; const int l = j / (N_WIN + N_WOUT); j -= l * (N_WIN + N_WOUT);
            if (j < N_WIN) transpose_tile(p.w_in + (size_t)l * 2048 * DIN, DIN, p.WinT + (size_t)l * NPAD * 2048, (j >> 3) * 64, (j & 7) * 256, true, lds);
            else { j -= N_WIN; transpose_tile(p.w_out + (size_t)l * 2048 * 2048, 2048, p.WoutT + (size_t)l * 2048 * 2048, (j >> 3) * 64, (j & 7) * 256, false, lds); }
        }
    }
}

DI void phase1(const Params& p, int l, const float* xin) {
    const int tid = get_tid(), w = tid >> 6, lane = tid & 63;
    const int nwav = gridDim.x * 8;
    for (int q = get_bid() * 8 + w; q < TT / 2; q += nwav) {
        const int b = q >> 10, r0 = b * 2048 + (q & 1023);
        const float* md = p.mod + (size_t)(l * 4 + b) * 6144;
        f32x4 v[2][8], nw[8], sh[8], sc[8];
#pragma unroll
        for (int u = 0; u < 2; ++u)
#pragma unroll
            for (int i = 0; i < 8; ++i) v[u][i] = *(const f32x4*)(xin + (size_t)(r0 + u * 1024) * DM + i * 256 + lane * 4);
#pragma unroll
        for (int i = 0; i < 8; ++i) {
            const int col = i * 256 + lane * 4;
            nw[i] = *(const f32x4*)(p.norm_w + l * 2048 + col); sh[i] = *(const f32x4*)(md + col); sc[i] = *(const f32x4*)(md + 2048 + col);
        }
        float ss[2] = {0.f, 0.f};
#pragma unroll
        for (int u = 0; u < 2; ++u) {
#pragma unroll
            for (int i = 0; i < 8; ++i) ss[u] += v[u][i][0] * v[u][i][0] + v[u][i][1] * v[u][i][1] + v[u][i][2] * v[u][i][2] + v[u][i][3] * v[u][i][3];
            ss[u] = sum16(ss[u]); ss[u] = xch16_add(ss[u]); ss[u] = xch32_add(ss[u]);
        }
#pragma unroll
        for (int u = 0; u < 2; ++u) {
            const float rstd = rsqrtf(ss[u] * (1.f / 2048.f) + 1e-6f);
#pragma unroll
            for (int i = 0; i < 8; ++i) {
                const f32x4 y = v[u][i] * rstd * nw[i] * (1.f + sc[i]) + sh[i];
                u32x2 o; o.x = cvt_pk_bf16(y[0], y[1]); o.y = cvt_pk_bf16(y[2], y[3]);
                *(u32x2*)(p.hbuf + (size_t)(r0 + u * 1024) * DM + i * 256 + lane * 4) = o;
            }
        }
    }
}

DI void gdn_prep(const Params& p, int l, int ci, unsigned char* lds, int stop) {
    const int tid = get_tid(), w = tid >> 6, lane = tid & 63, fr = lane & 15, q4 = lane >> 4;
    const int n = ci & 31, h = (ci >> 5) & 3, b = ci >> 7;
    const int t0 = b * SEQ + n * 64;
    constexpr int FS = 129;
    float* gcs = (float*)lds;
    float* bet = gcs + 64;
    float* rn = bet + 64;
    float* eg = rn + 128;
    float* egl = eg + 64;
    float* qf = egl + 64;
    float* kf = qf + 64 * FS;
    float* vf = kf + 64 * FS;
    float* Lm = vf + 64 * FS;
    bf16_t* qb = (bf16_t*)(Lm + 64 * 64);
    bf16_t* kb = qb + 64 * 136;
    bf16_t* raw = (bf16_t*)Lm;
    float cwt[3][4];
#pragma unroll
    for (int r = 0; r < 3; ++r) {
        const int chn = (tid + r * 512) % 384, seg = chn >> 7, d = chn & 127;
        const float* cw = p.gdn_conv_w + (size_t)l * 4 * 1536 + seg * 512 + h * 128 + d;
        cwt[r][0] = cw[0]; cwt[r][1] = cw[1536]; cwt[r][2] = cw[2 * 1536]; cwt[r][3] = cw[3 * 1536];
    }
    {
        u32x4 sv[7];
#pragma unroll
        for (int i = 0; i < 7; ++i) {
            const int e = tid + i * 512;
            const int row = e / 48, rem = e - row * 48, seg = rem >> 4, ch = rem & 15;
            sv[i] = (u32x4){0u, 0u, 0u, 0u};
            if (e < 67 * 48 && (n > 0 || row >= 3)) sv[i] = *(const u32x4*)(p.proj + (size_t)(t0 - 3 + row) * NPROJ + 1536 + seg * 512 + h * 128 + ch * 8);
        }
#pragma unroll
        for (int i = 0; i < 7; ++i) {
            const int e = tid + i * 512;
            const int row = e / 48, rem = e - row * 48, seg = rem >> 4, ch = rem & 15;
            if (e < 67 * 48) *(u32x4*)(raw + row * 384 + seg * 128 + ch * 8) = sv[i];
        }
    }
    if (tid < 64) {
        const int c = tid;
        const float da = p.small[(size_t)(t0 + c) * 32 + 16 + h], db = p.small[(size_t)(t0 + c) * 32 + 20 + h];
        const float xx = da + p.gdn_dt_bias[l * 4 + h];
        const float sp = xx > 20.f ? xx : log1pf(expf(xx));
        gcs[c] = -expf(p.gdn_a_log[l * 4 + h]) * sp;
        bet[c] = 1.f / (1.f + expf(-db));
    }
    __syncthreads();
#pragma unroll
    for (int r = 0; r < 3; ++r) {
        const int task = tid + r * 512;
        const int chn = task % 384, qt = task / 384;
        const int seg = chn >> 7, d = chn & 127;
        const float w0 = cwt[r][0], w1 = cwt[r][1], w2 = cwt[r][2], w3 = cwt[r][3];
        const bf16_t* rp = raw + (qt * 16) * 384 + seg * 128 + d;
        float xs[19];
#pragma unroll
        for (int c = 0; c < 19; ++c) xs[c] = bf2f(rp[c * 384]);
        float* dst = (seg == 0 ? qf : (seg == 1 ? kf : vf)) + (qt * 16) * FS + d;
#pragma unroll
        for (int c = 0; c < 16; ++c) {
            const float a = w0 * xs[c] + w1 * xs[c + 1] + w2 * xs[c + 2] + w3 * xs[c + 3];
            dst[c * FS] = a * __builtin_amdgcn_rcpf(1.f + __expf(-a));
        }
    }
    __syncthreads();
    if (stop == 1) return;
    {
        const int row = tid >> 2, sub = tid & 3;
        const float* src = (row < 64 ? qf + row * FS : kf + (row - 64) * FS);
        float s = 0.f;
        for (int i = 0; i < 32; ++i) { const float v = src[sub + 4 * i]; s += v * v; }
        s = sum4(s);
        if (sub == 0) rn[row] = rsqrtf(s + 1e-6f);
    }
    float gsum = 0.f;
    if (tid < 64) {
        gsum = gcs[tid];
#pragma unroll
        for (int o = 1; o < 64; o <<= 1) { const float t = __shfl_up(gsum, o); if (lane >= o) gsum += t; }
    }
    __syncthreads();
    if (tid < 64) gcs[tid] = gsum;
    { const float glast = __shfl(gsum, 63); if (tid < 64) { eg[tid] = __expf(gsum); egl[tid] = __expf(glast - gsum); } }
    for (int e = tid; e < 64 * 128; e += 512) {
        const int c = e >> 7, d = e & 127;
        const float qv = qf[c * FS + d] * rn[c] * 0.08838834764831845f, kv = kf[c * FS + d] * rn[64 + c];
        qf[c * FS + d] = qv; kf[c * FS + d] = kv;
        qb[c * 136 + d] = (bf16_t)(cvt_pk_bf16(qv, 0.f) & 0xffffu); kb[c * 136 + d] = (bf16_t)(cvt_pk_bf16(kv, 0.f) & 0xffffu);
    }
    __syncthreads();
    {
        const int ct = w >> 1;
        const int c = ct * 16 + fr;
        const float gc_c = gcs[c], be_c = bet[c];
#pragma unroll
        for (int i = 0; i < 2; ++i) {
            const int st = (w & 1) * 2 + i;
            f32x4 akk = {0.f, 0.f, 0.f, 0.f}, aqk = {0.f, 0.f, 0.f, 0.f};
            if (st <= ct) {
#pragma unroll
                for (int ks = 0; ks < 4; ++ks) {
                    const bf16x8 ak = *(const bf16x8*)(kb + (st * 16 + fr) * 136 + ks * 32 + q4 * 8);
                    const bf16x8 bk = *(const bf16x8*)(kb + (ct * 16 + fr) * 136 + ks * 32 + q4 * 8);
                    const bf16x8 bq = *(const bf16x8*)(qb + (ct * 16 + fr) * 136 + ks * 32 + q4 * 8);
                    akk = mfma16(ak, bk, akk); aqk = mfma16(ak, bq, aqk);
                }
            }
            f32x4 lv, qv;
#pragma unroll
            for (int r = 0; r < 4; ++r) {
                const int s = st * 16 + q4 * 4 + r;
                const float dec = (s <= c) ? __expf(gc_c - gcs[s]) : 0.f;
                lv[r] = (s < c) ? be_c * akk[r] * dec : 0.f;
                qv[r] = aqk[r] * dec;
            }
            *(f32x4*)(Lm + c * 64 + st * 16 + q4 * 4) = lv;
            u32x2 o; o.x = cvt_pk_bf16(qv[0], qv[1]); o.y = cvt_pk_bf16(qv[2], qv[3]);
            *(u32x2*)(p.dqk + (size_t)ci * 4096 + c * 64 + st * 16 + q4 * 4) = o;
        }
    }
    __syncthreads();
    if (stop == 2) { __syncthreads(); return; }
    if (tid >= 256) {
        const int t2 = tid - 256;
#pragma unroll
        for (int i = 0; i < 4; ++i) {
            const int e = t2 + i * 256; const int c = e >> 4, d = (e & 15) * 8; const float egc = eg[c];
            const u32x4 r = *(const u32x4*)(qb + c * 136 + d);
            u32x4 o; o.x = cvt_pk_bf16(bf_lo(r.x) * egc, bf_hi(r.x) * egc); o.y = cvt_pk_bf16(bf_lo(r.y) * egc, bf_hi(r.y) * egc);
            o.z = cvt_pk_bf16(bf_lo(r.z) * egc, bf_hi(r.z) * egc); o.w = cvt_pk_bf16(bf_lo(r.w) * egc, bf_hi(r.w) * egc);
            *(u32x4*)(p.dqe + (size_t)ci * 8192 + c * 128 + d) = o;
        }
#pragma unroll
        for (int i = 0; i < 4; ++i) {
            const int e = t2 + i * 256; const int d = e & 127, c = (e >> 7) * 8;
            float kv[8];
#pragma unroll
            for (int j = 0; j < 8; ++j) kv[j] = bf2f(kb[(c + j) * 136 + d]) * egl[c + j];
            u32x4 o; o.x = cvt_pk_bf16(kv[0], kv[1]); o.y = cvt_pk_bf16(kv[2], kv[3]); o.z = cvt_pk_bf16(kv[4], kv[5]); o.w = cvt_pk_bf16(kv[6], kv[7]);
            *(u32x4*)(p.dktT + (size_t)ci * 8192 + d * 64 + c) = o;
        }
        if (t2 == 0) p.dcd[ci] = eg[63];
    } else if (stop != 3) {
        const int j = tid & 127; const bool isw = tid >= 128;
        float* X = (isw ? kf : vf) + j;
        int zoff; asm volatile("v_mov_b32 %0, 0" : "=v"(zoff));
        const float* Lz = Lm + zoff;
#pragma unroll 1
        for (int rb = 0; rb < 4; ++rb) {
            float a[16];
#pragma unroll
            for (int r = 0; r < 16; ++r) { const int i = rb * 16 + r; float v = X[i * FS] * bet[i]; if (isw) v *= eg[i]; a[r] = v; }
#pragma unroll 1
            for (int j4 = 0; j4 < rb * 4; ++j4) {
                const float x0 = X[(j4 * 4 + 0) * FS], x1 = X[(j4 * 4 + 1) * FS], x2 = X[(j4 * 4 + 2) * FS], x3 = X[(j4 * 4 + 3) * FS];
#pragma unroll
                for (int r = 0; r < 16; ++r) {
                    const f32x4 lv = *(const f32x4*)(Lz + (rb * 16 + r) * 64 + j4 * 4);
                    a[r] -= lv[0] * x0; a[r] -= lv[1] * x1; a[r] -= lv[2] * x2; a[r] -= lv[3] * x3;
                }
            }
#pragma unroll
            for (int r = 1; r < 16; ++r) {
#pragma unroll
                for (int r2 = 0; r2 < r; ++r2) a[r] -= Lz[(rb * 16 + r) * 64 + rb * 16 + r2] * a[r2];
            }
#pragma unroll
            for (int r = 0; r < 16; ++r) X[(rb * 16 + r) * FS] = a[r];
            if (!isw) {
#pragma unroll
                for (int r = 0; r < 16; ++r) p.du[(size_t)ci * 8192 + (rb * 16 + r) * 128 + j] = a[r];
            } else {
#pragma unroll
                for (int r = 0; r < 16; ++r) p.dw[(size_t)ci * 8192 + (rb * 16 + r) * 128 + j] = (bf16_t)(cvt_pk_bf16(a[r], 0.f) & 0xffffu);
            }
        }
    }
    __syncthreads();
}

DI void gla_prep(const Params& p, int l, int bn, unsigned char* lds) {
    const int tid = get_tid(), w = tid >> 6, lane = tid & 63, fr = lane & 15, q4 = lane >> 4;
    const int n = bn & 31, b = bn >> 5;
    const int t0 = b * SEQ + n * 64;
    float* glr = (float*)lds;
    float* bcum = glr + 64 * 16;
    bf16_t* qe_s = (bf16_t*)(bcum + 64 * 256);
    bf16_t* ke_s = qe_s + 64 * 72;
    bf16_t* kdT_s = ke_s + 64 * 72;
    bf16_t* vT_s = kdT_s + 64 * 72;
    u32x4 qr4[4], kr4[4], va4[4], vb4[4];
    {
        const int c = tid >> 3, ds = (tid & 7) * 8, dv0 = (tid & 7) * 16;
        const bf16_t* rowp = p.proj + (size_t)(t0 + c) * NPROJ;
#pragma unroll
        for (int h = 0; h < 4; ++h) {
            qr4[h] = *(const u32x4*)(rowp + h * 64 + ds); kr4[h] = *(const u32x4*)(rowp + 256 + h * 64 + ds);
            va4[h] = *(const u32x4*)(rowp + 512 + h * 128 + dv0); vb4[h] = *(const u32x4*)(rowp + 512 + h * 128 + dv0 + 8);
        }
    }
    float wl[16]; float bl;
#pragma unroll
    for (int r = 0; r < 16; ++r) wl[r] = p.gla_w_lr[(size_t)l * 16 * 256 + r * 256 + (tid & 255)];
    bl = p.gla_b_lr[l * 256 + (tid & 255)];
    if (tid < 256) { const int c = tid >> 2, r4 = (tid & 3) * 4; *(f32x4*)(glr + c * 16 + r4) = *(const f32x4*)(p.small + (size_t)(t0 + c) * 32 + r4); }
    __syncthreads();
    {
        const int col = tid & 255, c0 = (tid >> 8) * 32;
        float run = 0.f;
#pragma unroll 4
        for (int c = c0; c < c0 + 32; ++c) {
            float z = bl;
#pragma unroll
            for (int r = 0; r < 16; ++r) z += glr[c * 16 + r] * wl[r];
            const float la = (fminf(z, 0.f) - __logf(1.f + __expf(-fabsf(z)))) * (1.f / 16.f);
            run += la; bcum[c * 256 + col] = run;
        }
    }
    __syncthreads();
#pragma unroll
    for (int h = 0; h < 4; ++h) {
        const int ci = (b * 4 + h) * 32 + n;
        bf16_t* qe_h = qe_s + (h & 1) * 23040;
        bf16_t* ke_h = qe_h + 64 * 72;
        bf16_t* kdT_h = ke_h + 64 * 72;
        bf16_t* vT_h = kdT_h + 64 * 72;
        {
            const int c = tid >> 3, ds = (tid & 7) * 8, sw = (tid & 7) * 8;
            const u32x4 qr = qr4[h];
            const u32x4 kr = kr4[h];
            float qv[8], kv[8], bv[8], bl8[8];
#pragma unroll
            for (int j = 0; j < 4; ++j) { qv[2 * j] = bf_lo(qr[j]); qv[2 * j + 1] = bf_hi(qr[j]); kv[2 * j] = bf_lo(kr[j]); kv[2 * j + 1] = bf_hi(kr[j]); }
#pragma unroll
            for (int j = 0; j < 8; ++j) {
                const float t1 = bcum[31 * 256 + h * 64 + ds + j];
                bv[j] = bcum[c * 256 + h * 64 + ds + j] + (c >= 32 ? t1 : 0.f);
                bl8[j] = bcum[63 * 256 + h * 64 + ds + j] + t1;
            }
            u32x4 qo, ko;
#pragma unroll
            for (int j = 0; j < 4; ++j) {
                qo[j] = cvt_pk_bf16(qv[2 * j] * 0.125f * __expf(bv[2 * j]), qv[2 * j + 1] * 0.125f * __expf(bv[2 * j + 1]));
                ko[j] = cvt_pk_bf16(kv[2 * j] * __expf(-bv[2 * j]), kv[2 * j + 1] * __expf(-bv[2 * j + 1]));
            }
            *(u32x4*)(qe_h + c * 72 + ds) = qo; *(u32x4*)(ke_h + c * 72 + ds) = ko;
            *(u32x4*)(p.gqe + (size_t)ci * 4096 + c * 64 + ds) = qo;
#pragma unroll
            for (int j = 0; j < 8; ++j) kdT_h[(ds + j) * 72 + (c ^ sw)] = (bf16_t)(cvt_pk_bf16(kv[j] * __expf(bl8[j] - bv[j]), 0.f) & 0xffffu);
            const int dv0 = (tid & 7) * 16;
            const u32x4 v0 = va4[h];
            const u32x4 v1 = vb4[h];
#pragma unroll
            for (int j = 0; j < 4; ++j) {
                vT_h[(dv0 + 2 * j) * 72 + (c ^ sw)] = (bf16_t)(v0[j] & 0xffffu); vT_h[(dv0 + 2 * j + 1) * 72 + (c ^ sw)] = (bf16_t)(v0[j] >> 16);
                vT_h[(dv0 + 8 + 2 * j) * 72 + (c ^ sw)] = (bf16_t)(v1[j] & 0xffffu); vT_h[(dv0 + 8 + 2 * j + 1) * 72 + (c ^ sw)] = (bf16_t)(v1[j] >> 16);
            }
            if (tid < 64) p.gdec[(size_t)ci * 64 + tid] = __expf(bcum[63 * 256 + h * 64 + tid] + bcum[31 * 256 + h * 64 + tid]);
        }
        __syncthreads();
#pragma unroll
        for (int i = 0; i < 2; ++i) {
            const int id = w * 2 + i, ct = id >> 2, st = id & 3;
            f32x4 a = {0.f, 0.f, 0.f, 0.f};
            if (st <= ct) {
#pragma unroll
                for (int ks = 0; ks < 2; ++ks) {
                    const bf16x8 ak = *(const bf16x8*)(ke_h + (st * 16 + fr) * 72 + ks * 32 + q4 * 8);
                    const bf16x8 bq = *(const bf16x8*)(qe_h + (ct * 16 + fr) * 72 + ks * 32 + q4 * 8);
                    a = mfma16(ak, bq, a);
                }
            }
            const int c = ct * 16 + fr;
#pragma unroll
            for (int r = 0; r < 4; ++r) { const int s2 = st * 16 + q4 * 4 + r; if (s2 > c) a[r] = 0.f; }
            u32x2 o; o.x = cvt_pk_bf16(a[0], a[1]); o.y = cvt_pk_bf16(a[2], a[3]);
            *(u32x2*)(p.gatt + (size_t)ci * 4096 + c * 64 + st * 16 + q4 * 4) = o;
        }
        {
            const int r = tid >> 3, cs = (tid & 7) * 8;
            *(u32x4*)(p.gkdT + (size_t)ci * 4096 + r * 64 + cs) = *(const u32x4*)(kdT_h + r * 72 + (cs ^ (((r >> 3) & 7) * 8)));
            *(u32x4*)(p.gvT + (size_t)ci * 8192 + r * 64 + cs) = *(const u32x4*)(vT_h + r * 72 + (cs ^ (((r >> 4) & 7) * 8)));
            *(u32x4*)(p.gvT + (size_t)ci * 8192 + (64 + r) * 64 + cs) = *(const u32x4*)(vT_h + (64 + r) * 72 + (cs ^ ((((64 + r) >> 4) & 7) * 8)));
        }
    }
    __syncthreads();
}

DI void diff_prep(const Params& p, int l, int tile, unsigned char* lds) {
    const int tid = get_tid();
    const int t0 = tile * 64, b = t0 >> 11, s0 = t0 & 2047;
    bf16_t* vs = (bf16_t*)lds;
    {
        const int g = tid >> 4, i16 = tid & 15;
        const int d0 = i16 * 8, fi = (i16 & 7) * 8;
        float qw[8], kw[8];
#pragma unroll
        for (int j = 0; j < 8; ++j) { qw[j] = p.diff_q_norm_w[l * 128 + d0 + j]; kw[j] = p.diff_k_norm_w[l * 128 + d0 + j]; }
#pragma unroll 1
        for (int pass = 0; pass < 2; ++pass) {
            const int tk = pass * 32 + g, t = t0 + tk;
            const f32x4 cs0 = *(const f32x4*)(p.rope + (size_t)t * 128 + fi), cs1 = *(const f32x4*)(p.rope + (size_t)t * 128 + fi + 4);
            const f32x4 sn0 = *(const f32x4*)(p.rope + (size_t)t * 128 + 64 + fi), sn1 = *(const f32x4*)(p.rope + (size_t)t * 128 + 64 + fi + 4);
            u32x4 vreg[8];
#pragma unroll
            for (int i = 0; i < 8; ++i) { const int e = tid + (pass * 8 + i) * 512; vreg[i] = *(const u32x4*)(p.proj + (size_t)(t0 + (e >> 7)) * NPROJ + 5632 + (e & 127) * 8); }
            u32x4 raw16[16];
#pragma unroll
            for (int vec = 0; vec < 16; ++vec) raw16[vec] = *(const u32x4*)(p.proj + (size_t)t * NPROJ + 3584 + vec * 128 + d0);
#pragma unroll
            for (int i = 0; i < 8; ++i) { const int e = tid + (pass * 8 + i) * 512; *(u32x4*)(vs + (e >> 7) * 1032 + (e & 127) * 8) = vreg[i]; }
#pragma unroll
            for (int vec = 0; vec < 16; ++vec) {
                const int isk = vec >> 3, hm = vec & 7;
                float v[8];
#pragma unroll
                for (int j = 0; j < 4; ++j) { v[2 * j] = bf_lo(raw16[vec][j]); v[2 * j + 1] = bf_hi(raw16[vec][j]); }
                float ss = 0.f;
#pragma unroll
                for (int j = 0; j < 8; ++j) ss += v[j] * v[j];
                ss = sum16(ss);
                const float rstd = rsqrtf(ss * (1.f / 128.f) + 1e-6f);
                const float sc = isk ? 1.f : 0.08838834764831845f * 1.4426950408889634f;
                float o[8];
#pragma unroll
                for (int j = 0; j < 8; ++j) {
                    const float y = v[j] * rstd * (isk ? kw[j] : qw[j]);
                    const float oth = dpp_f<0x128>(y);
                    const float cs = (j < 4 ? cs0 : cs1)[j & 3], sn = (j < 4 ? sn0 : sn1)[j & 3];
                    o[j] = ((i16 < 8) ? (y * cs - oth * sn) : (y * cs + oth * sn)) * sc;
                }
                u32x4 ov; ov.x = cvt_pk_bf16(o[0], o[1]); ov.y = cvt_pk_bf16(o[2], o[3]); ov.z = cvt_pk_bf16(o[4], o[5]); ov.w = cvt_pk_bf16(o[6], o[7]);
                bf16_t* dst = (isk ? p.kd : p.qd) + ((size_t)((b * 8 + hm) * SEQ + s0 + tk)) * 128 + d0;
                *(u32x4*)dst = ov;
            }
        }
    }
    __syncthreads();
    {
        const int c2 = tid * 2, hh = c2 >> 8, dv = c2 & 255;
        bf16_t* dst = p.vT + ((size_t)((b * 4 + hh) * 32 + (s0 >> 6)) * 256 + dv) * 64;
#pragma unroll
        for (int seg = 0; seg < 8; ++seg) {
            unsigned wv[8];
#pragma unroll
            for (int j = 0; j < 8; ++j) wv[j] = *(const unsigned*)(vs + (seg * 8 + j) * 1032 + c2);
            u32x4 r0, r1;
#pragma unroll
            for (int j = 0; j < 4; ++j) { r0[j] = (wv[2 * j] & 0xffffu) | (wv[2 * j + 1] << 16); r1[j] = (wv[2 * j] >> 16) | (wv[2 * j + 1] & 0xffff0000u); }
            *(u32x4*)(dst + seg * 8) = r0; *(u32x4*)(dst + 64 + seg * 8) = r1;
        }
    }
    __syncthreads();
}

DI void phase3(const Params& p, int l, unsigned char* lds, int mask, int stop) {
    for (int it = get_bid(); it < 768; it += gridDim.x) {
        if (it < 512) { if (mask & 1) gdn_prep(p, l, it, lds, stop); }
        else if (it < 640) { if (mask & 2) gla_prep(p, l, it - 512, lds); }
        else if (mask & 4) diff_prep(p, l, it - 640, lds);
    }
}

DI void lds_barrier() { asm volatile("s_waitcnt lgkmcnt(0)" ::: "memory"); __builtin_amdgcn_s_barrier(); asm volatile("" ::: "memory"); }

struct GlaOps { bf16x8 att[2], vt[2][2], qe[2], kd[2]; f32x4 dec; };
DI void gla_load(const Params& p, size_t ci, int t2, int dh, int sl, int fr, int q4, GlaOps& o) {
    const bf16_t* att = p.gatt + ci * 4096 + (t2 * 16 + fr) * 64 + q4 * 8;
    const bf16_t* qe = p.gqe + ci * 4096 + (t2 * 16 + fr) * 64 + q4 * 8;
    const bf16_t* kdT = p.gkdT + ci * 4096 + (t2 * 16 + fr) * 64 + q4 * 8;
#pragma unroll
    for (int ks = 0; ks < 2; ++ks) { o.att[ks] = *(const bf16x8*)(att + ks * 32); o.qe[ks] = *(const bf16x8*)(qe + ks * 32); o.kd[ks] = *(const bf16x8*)(kdT + ks * 32); }
#pragma unroll
    for (int e = 0; e < 2; ++e) {
        const bf16_t* vT = p.gvT + ci * 8192 + (size_t)(sl * 64 + (2 * dh + e) * 16 + fr) * 64 + q4 * 8;
#pragma unroll
        for (int ks = 0; ks < 2; ++ks) o.vt[e][ks] = *(const bf16x8*)(vT + ks * 32);
    }
    o.dec = *(const f32x4*)(p.gdec + ci * 64 + t2 * 16 + q4 * 4);
}
DI void gla_chain(const Params& p, int id, unsigned char* lds) {
    const int tid = get_tid(), w = tid >> 6, lane = tid & 63, fr = lane & 15, q4 = lane >> 4;
    const int sl = id & 1, bh = id >> 1;
    bf16_t* St = (bf16_t*)lds;
    const int t2 = w >> 1, dh = w & 1;
    const int b = bh >> 2, h = bh & 3;
    f32x4 Sacc[2] = {{0.f, 0.f, 0.f, 0.f}, {0.f, 0.f, 0.f, 0.f}};
    auto step = [&](int n, const GlaOps& cur) {
#pragma unroll
        for (int e = 0; e < 2; ++e) { u32x2 o; o.x = cvt_pk_bf16(Sacc[e][0], Sacc[e][1]); o.y = cvt_pk_bf16(Sacc[e][2], Sacc[e][3]);
          *(u32x2*)(St + ((2 * dh + e) * 16 + fr) * 72 + t2 * 16 + q4 * 4) = o; }
        lds_barrier();
#pragma unroll
        for (int e = 0; e < 2; ++e) {
            f32x4 o = {0.f, 0.f, 0.f, 0.f};
#pragma unroll
            for (int ks = 0; ks < 2; ++ks) o = mfma16(cur.att[ks], cur.vt[e][ks], o);
#pragma unroll
            for (int ks = 0; ks < 2; ++ks) {
                const bf16x8 bs = *(const bf16x8*)(St + ((2 * dh + e) * 16 + fr) * 72 + ks * 32 + q4 * 8);
                o = mfma16(cur.qe[ks], bs, o);
            }
            float* dst = p.ogla + (size_t)(b * SEQ + n * 64 + t2 * 16 + q4 * 4) * 512 + h * 128 + sl * 64 + (2 * dh + e) * 16 + fr;
#pragma unroll
            for (int r = 0; r < 4; ++r) dst[r * 512] = o[r];
            Sacc[e] = Sacc[e] * cur.dec;
#pragma unroll
            for (int ks = 0; ks < 2; ++ks) Sacc[e] = mfma16(cur.kd[ks], cur.vt[e][ks], Sacc[e]);
        }
        lds_barrier();
    };
    GlaOps r0, r1, r2;
    const size_t c0 = (size_t)bh * 32;
    gla_load(p, c0 + 0, t2, dh, sl, fr, q4, r0); gla_load(p, c0 + 1, t2, dh, sl, fr, q4, r1); gla_load(p, c0 + 2, t2, dh, sl, fr, q4, r2);
#pragma unroll 1
    for (int n = 0; n < 33; n += 3) {
        step(n, r0);     gla_load(p, c0 + min(n + 3, 31), t2, dh, sl, fr, q4, r0);
        step(n + 1, r1); gla_load(p, c0 + min(n + 4, 31), t2, dh, sl, fr, q4, r1);
        if (n + 2 < 32) { step(n + 2, r2); gla_load(p, c0 + min(n + 5, 31), t2, dh, sl, fr, q4, r2); }
    }
}

struct GdnOps { bf16x8 am[4], qk[2], kt[2]; float u[4][4]; float cd; };
DI void gdn_load(const Params& p, size_t ci, int w, int ct, int role, int sl, int fr, int q4, GdnOps& o) {
    const bf16_t* am = (role ? p.dqe : p.dw) + ci * 8192 + (ct * 16 + fr) * 128 + q4 * 8;
    const bf16_t* ktT = p.dktT + ci * 8192 + (w * 16 + fr) * 64 + q4 * 8;
#pragma unroll
    for (int ks = 0; ks < 4; ++ks) o.am[ks] = *(const bf16x8*)(am + ks * 32);
#pragma unroll
    for (int ks = 0; ks < 2; ++ks) o.kt[ks] = *(const bf16x8*)(ktT + ks * 32);
    if (role) {
        const bf16_t* qk = p.dqk + ci * 4096 + (ct * 16 + fr) * 64 + q4 * 8;
#pragma unroll
        for (int ks = 0; ks < 2; ++ks) o.qk[ks] = *(const bf16x8*)(qk + ks * 32);
    } else {
#pragma unroll
        for (int e = 0; e < 4; ++e) {
            const float* up = p.du + ci * 8192 + (size_t)(ct * 16 + q4 * 4) * 128 + sl * 64 + e * 16 + fr;
#pragma unroll
            for (int r = 0; r < 4; ++r) o.u[e][r] = up[r * 128];
        }
    }
    o.cd = p.dcd[ci];
}
DI void gdn_chain(const Params& p, int id, unsigned char* lds) {
    const int tid = get_tid(), w = __builtin_amdgcn_readfirstlane(tid >> 6), lane = tid & 63, fr = lane & 15, q4 = lane >> 4;
    const int sl = id & 1, bh = id >> 1;
    bf16_t* St = (bf16_t*)lds;
    bf16_t* VnT = St + 64 * 136;
    const int ct = w >> 1, role = w & 1;
    f32x4 S[4];
#pragma unroll
    for (int i = 0; i < 4; ++i) S[i] = (f32x4){0.f, 0.f, 0.f, 0.f};
    const int b = bh >> 2, h = bh & 3;
    auto step = [&](int n, const GdnOps& cur) {
#pragma unroll
        for (int d = 0; d < 4; ++d) { u32x2 o; o.x = cvt_pk_bf16(S[d][0], S[d][1]); o.y = cvt_pk_bf16(S[d][2], S[d][3]);
          *(u32x2*)(St + (d * 16 + fr) * 136 + w * 16 + q4 * 4) = o; }
        lds_barrier();
        f32x4 acc[4];
#pragma unroll
        for (int e = 0; e < 4; ++e) {
            acc[e] = (f32x4){0.f, 0.f, 0.f, 0.f};
#pragma unroll
            for (int ks = 0; ks < 4; ++ks) {
                const bf16x8 bs = *(const bf16x8*)(St + (e * 16 + fr) * 136 + ks * 32 + q4 * 8);
                acc[e] = mfma16(cur.am[ks], bs, acc[e]);
            }
        }
        if (role == 0) {
#pragma unroll
            for (int e = 0; e < 4; ++e) {
                u32x2 pk; pk.x = cvt_pk_bf16(cur.u[e][0] - acc[e][0], cur.u[e][1] - acc[e][1]); pk.y = cvt_pk_bf16(cur.u[e][2] - acc[e][2], cur.u[e][3] - acc[e][3]);
                *(u32x2*)(VnT + (e * 16 + fr) * 72 + ct * 16 + q4 * 4) = pk;
            }
        }
        lds_barrier();
        if (role == 1) {
#pragma unroll
            for (int e = 0; e < 4; ++e) {
#pragma unroll
                for (int ks = 0; ks < 2; ++ks) { const bf16x8 bo = *(const bf16x8*)(VnT + (e * 16 + fr) * 72 + ks * 32 + q4 * 8); acc[e] = mfma16(cur.qk[ks], bo, acc[e]); }
                float* dst = p.ogdn + (size_t)(b * SEQ + n * 64 + ct * 16 + q4 * 4) * 512 + h * 128 + sl * 64 + e * 16 + fr;
#pragma unroll
                for (int r = 0; r < 4; ++r) dst[r * 512] = acc[e][r];
            }
        }
#pragma unroll
        for (int d = 0; d < 4; ++d) {
            S[d] = S[d] * cur.cd;
#pragma unroll
            for (int ks = 0; ks < 2; ++ks) { const bf16x8 bv = *(const bf16x8*)(VnT + (d * 16 + fr) * 72 + ks * 32 + q4 * 8); S[d] = mfma16(cur.kt[ks], bv, S[d]); }
        }
    };
    GdnOps r0, r1;
    const size_t c0 = (size_t)bh * 32;
    gdn_load(p, c0 + 0, w, ct, role, sl, fr, q4, r0); gdn_load(p, c0 + 1, w, ct, role, sl, fr, q4, r1);
#pragma unroll 1
    for (int n = 0; n < 32; n += 2) {
        step(n, r0);     gdn_load(p, c0 + min(n + 2, 31), w, ct, role, sl, fr, q4, r0);
        step(n + 1, r1); gdn_load(p, c0 + min(n + 3, 31), w, ct, role, sl, fr, q4, r1);
    }
    __syncthreads();
}

DI void attn_item(const Params& p, int l, int item, unsigned char* lds, int ktmul) {
    const int tid = get_tid(), w = __builtin_amdgcn_readfirstlane(tid >> 6), lane = tid & 63, fr = lane & 15, q4 = lane >> 4;
    const int qb = 31 - (item >> 4), bh = item & 15, b = bh >> 2, h = bh & 3;
    const int m = w >> 2, rt = w & 3;
    const int q0 = qb * 64;
    const float lam = p.lam[l];
    LAS unsigned char* L = (LAS unsigned char*)lds;
    const bf16_t* qg = p.qd + ((size_t)((b * 8 + h * 2 + m) * SEQ + q0 + rt * 16 + fr)) * 128;
    bf16x8 qf[4];
#pragma unroll
    for (int ks = 0; ks < 4; ++ks) qf[ks] = *(const bf16x8*)(qg + ks * 32 + q4 * 8);
    const bf16_t* kg = p.kd + ((size_t)(b * 8 + h * 2) * SEQ) * 128;
    const bf16_t* vg = p.vT + ((size_t)(b * 4 + h) * 32) * 16384;
    unsigned koff[4], voff[4];
#pragma unroll
    for (int i = 0; i < 4; ++i) {
        const int gk = w * 4 + i;
        const int rk = gk * 4 + (lane >> 4), ck = (lane & 15) ^ ((rk & 3) | (((rk >> 3) & 3) << 2));
        koff[i] = (unsigned)(((rk >> 6) * SEQ + (rk & 63)) * 128 + ck * 8);
        const int gv = w * 4 + i;
        const int rv = gv * 8 + (lane >> 3), cv = (lane & 7) ^ ((rv >> 1) & 7);
        voff[i] = (unsigned)(rv * 64 + cv * 8);
    }
    auto issue_tile = [&](int kt, int buf) {
#pragma unroll
        for (int i = 0; i < 4; ++i) {
            __builtin_amdgcn_global_load_lds((const unsigned*)(kg + (size_t)kt * 64 * 128 + koff[i]), (LAS unsigned*)(L + buf * 65536 + (w * 4 + i) * 1024), 16, 0, 0);
            __builtin_amdgcn_global_load_lds((const unsigned*)(vg + (size_t)kt * 16384 + voff[i]), (LAS unsigned*)(L + buf * 65536 + 32768 + (w * 4 + i) * 1024), 16, 0, 0);
        }
    };
    f32x4 O[16];
#pragma unroll
    for (int i = 0; i < 16; ++i) O[i] = (f32x4){0.f, 0.f, 0.f, 0.f};
    float mrun = 0.f, lrun = 0.f;
    const int qglob = q0 + rt * 16 + fr;
    const int krow = (fr >> 2) * 8 + (fr & 3);
    const unsigned kro = (unsigned)((m * 64 + krow) * 256);
    const unsigned vro = (unsigned)(fr * 128);
    const int vsw = (fr >> 1) & 7;
    issue_tile(0, 0);
    for (int kt = 0; kt <= qb; ++kt) {
        asm volatile("s_waitcnt vmcnt(0)" ::: "memory");
        __syncthreads();
        const int buf = kt & 1;
        if (kt < qb) issue_tile((kt + 1) * ktmul, buf ^ 1);
        const LAS unsigned char* Kb = L + buf * 65536 + kro;
        const LAS unsigned char* Vb = L + buf * 65536 + 32768 + vro;
        f32x4 sc[4];
        const float negm = -mrun;
#pragma unroll
        for (int j = 0; j < 4; ++j) {
            sc[j] = (f32x4){negm, negm, negm, negm};
#pragma unroll
            for (int ks = 0; ks < 4; ++ks) {
                const bf16x8 a = *(const LAS bf16x8*)(Kb + ((j >> 1) * 32 + (j & 1) * 4) * 256 + (((ks * 4 + q4) ^ fr) << 4));
                sc[j] = mfma16(a, qf[ks], sc[j]);
            }
        }
        if (kt == qb) {
#pragma unroll
            for (int j = 0; j < 4; ++j)
#pragma unroll
                for (int r = 0; r < 4; ++r) if (kt * 64 + (j >> 1) * 32 + q4 * 8 + (j & 1) * 4 + r > qglob) sc[j][r] = -1e30f;
        }
        float tm = -1e30f;
#pragma unroll
        for (int j = 0; j < 4; ++j)
#pragma unroll
            for (int r = 0; r < 4; ++r) tm = fmaxf(tm, sc[j][r]);
        tm = xch16_max(tm); tm = xch32_max(tm);
        if (__builtin_amdgcn_ballot_w64(tm > 6.0f) != 0ull) {
            const float d = fmaxf(tm, 0.f);
            const float alpha = __builtin_amdgcn_exp2f(-d);
            mrun += d;
            lrun *= alpha;
#pragma unroll
            for (int i = 0; i < 16; ++i) O[i] = O[i] * alpha;
#pragma unroll
            for (int j = 0; j < 4; ++j)
#pragma unroll
                for (int r = 0; r < 4; ++r) sc[j][r] -= d;
        }
        float ps = 0.f;
#pragma unroll
        for (int j = 0; j < 4; ++j)
#pragma unroll
            for (int r = 0; r < 4; ++r) { const float pv = __builtin_amdgcn_exp2f(sc[j][r]); sc[j][r] = pv; ps += pv; }
        lrun += ps;
        bf16x8 pf[2];
#pragma unroll
        for (int k2 = 0; k2 < 2; ++k2) {
            u32x4 t; t.x = cvt_pk_bf16(sc[2 * k2][0], sc[2 * k2][1]); t.y = cvt_pk_bf16(sc[2 * k2][2], sc[2 * k2][3]);
            t.z = cvt_pk_bf16(sc[2 * k2 + 1][0], sc[2 * k2 + 1][1]); t.w = cvt_pk_bf16(sc[2 * k2 + 1][2], sc[2 * k2 + 1][3]);
            pf[k2] = as_bf16x8(t);
        }
#pragma unroll
        for (int dvt = 0; dvt < 16; ++dvt)
#pragma unroll
            for (int k2 = 0; k2 < 2; ++k2) {
                const bf16x8 av = *(const LAS bf16x8*)(Vb + dvt * 2048 + (((4 * k2 + q4) ^ vsw) << 4));
                O[dvt] = mfma16(av, pf[k2], O[dvt]);
            }
    }
    lrun = xch16_add(lrun); lrun = xch32_add(lrun);
    const float fac = (m == 0 ? 1.f : lam) / lrun;
    __syncthreads();
    float* Ox = (float*)lds;
    if (m == 1) {
#pragma unroll
        for (int dvt = 0; dvt < 16; ++dvt) *(f32x4*)(Ox + (rt * 16 + fr) * 260 + dvt * 16 + q4 * 4) = O[dvt] * fac;
    }
    __syncthreads();
    if (m == 0) {
        float ss = 0.f;
#pragma unroll
        for (int dvt = 0; dvt < 16; ++dvt) {
            const f32x4 o2 = *(const f32x4*)(Ox + (rt * 16 + fr) * 260 + dvt * 16 + q4 * 4);
            O[dvt] = O[dvt] * fac - o2;
            ss += O[dvt][0] * O[dvt][0] + O[dvt][1] * O[dvt][1] + O[dvt][2] * O[dvt][2] + O[dvt][3] * O[dvt][3];
        }
        ss = xch16_add(ss); ss = xch32_add(ss);
        const float lam_init = 0.8f - 0.6f * expf(-0.3f * (float)l);
        const float rstd = rsqrtf(ss * (1.f / 256.f) + 1e-6f) * (1.f - lam_init);
        const size_t t = (size_t)b * SEQ + qglob;
        u32x2 zr16[16]; f32x4 nw16[16];
#pragma unroll
        for (int dvt = 0; dvt < 16; ++dvt) {
            zr16[dvt] = *(const u32x2*)(p.proj + t * NPROJ + 6656 + h * 256 + dvt * 16 + q4 * 4);
            nw16[dvt] = *(const f32x4*)(p.diff_norm_w + l * 256 + dvt * 16 + q4 * 4);
        }
#pragma unroll
        for (int dvt = 0; dvt < 16; ++dvt) {
            const int dv = dvt * 16 + q4 * 4;
            const f32x4 nw = nw16[dvt];
            const u32x2 zr = zr16[dvt];
            const float z0 = bf_lo(zr.x), z1 = bf_hi(zr.x), z2 = bf_lo(zr.y), z3 = bf_hi(zr.y);
            u32x2 ov;
            ov.x = cvt_pk_bf16(O[dvt][0] * rstd * nw[0] * siluf(z0), O[dvt][1] * rstd * nw[1] * siluf(z1));
            ov.y = cvt_pk_bf16(O[dvt][2] * rstd * nw[2] * siluf(z2), O[dvt][3] * rstd * nw[3] * siluf(z3));
            *(u32x2*)(p.concat + t * DM + 1024 + h * 256 + dv) = ov;
        }
    }
    __syncthreads();
}

DI void phase4(const Params& p, int lc, unsigned char* lds) {
    const int l = lc & 1;
    const int bid = get_bid();
    if (!((PROBE_PHASE == 42 || PROBE_PHASE == 43) && lc >= 2)) {
    if (bid < 32) gdn_chain(p, bid, lds);
    else if (bid < 64) gla_chain(p, bid - 32, lds);
    }
    if (PROBE_PHASE == 41 && lc >= 2) return;
    unsigned* slot = (unsigned*)(lds + LDS_BYTES - 16);
    const int xcd = bid & 7;
    for (;;) {
        __syncthreads();
        if (get_tid() == 0) *slot = atomicAdd(p.cnt + lc * 8 + xcd, 1u);
        __syncthreads();
        const unsigned idx = *slot;
        if (idx >= 64u) break;
        attn_item(p, l, (int)(((idx >> 1) << 4) | (2 * xcd + (idx & 1))), lds, (PROBE_PHASE == 43 && lc >= 2) ? 0 : 1);
    }
}

DI void phase5(const Params& p, int l) {
    const int tid = get_tid();
    const int i16 = tid & 15;
    const int gidx = get_bid() * 32 + (tid >> 4), gstride = gridDim.x * 32;
    const f32x4 nwa0 = *(const f32x4*)(p.gla_norm_w + l * 128 + i16 * 8), nwa1 = *(const f32x4*)(p.gla_norm_w + l * 128 + i16 * 8 + 4);
    const f32x4 nwd0 = *(const f32x4*)(p.gdn_norm_w + l * 128 + i16 * 8), nwd1 = *(const f32x4*)(p.gdn_norm_w + l * 128 + i16 * 8 + 4);
    for (int it0 = gidx; it0 < TT * 8; it0 += 4 * gstride) {
        f32x4 v0[4], v1[4]; u32x4 zr[4];
#pragma unroll
        for (int u = 0; u < 4; ++u) {
            int it = it0 + u * gstride; if (it >= TT * 8) it = it0; const int t = it >> 3, g = (it >> 2) & 1, h = it & 3;
            const float* src = (g ? p.ogdn : p.ogla) + (size_t)t * 512 + h * 128 + i16 * 8;
            v0[u] = *(const f32x4*)src; v1[u] = *(const f32x4*)(src + 4);
            zr[u] = *(const u32x4*)(p.proj + (size_t)t * NPROJ + (g ? 3072 : 1024) + h * 128 + i16 * 8);
        }
#pragma unroll
        for (int u = 0; u < 4; ++u) {
            const int it = it0 + u * gstride; if (it >= TT * 8) break; const int t = it >> 3, g = (it >> 2) & 1, h = it & 3;
            float ss = v0[u][0] * v0[u][0] + v0[u][1] * v0[u][1] + v0[u][2] * v0[u][2] + v0[u][3] * v0[u][3]
                     + v1[u][0] * v1[u][0] + v1[u][1] * v1[u][1] + v1[u][2] * v1[u][2] + v1[u][3] * v1[u][3];
            ss = sum16(ss);
            const float rstd = rsqrtf(ss * (1.f / 128.f) + 1e-6f);
            const f32x4 n0 = g ? nwd0 : nwa0, n1 = g ? nwd1 : nwa1;
            u32x4 o;
            o.x = cvt_pk_bf16(v0[u][0] * rstd * n0[0] * siluf(bf_lo(zr[u].x)), v0[u][1] * rstd * n0[1] * siluf(bf_hi(zr[u].x)));
            o.y = cvt_pk_bf16(v0[u][2] * rstd * n0[2] * siluf(bf_lo(zr[u].y)), v0[u][3] * rstd * n0[3] * siluf(bf_hi(zr[u].y)));
            o.z = cvt_pk_bf16(v1[u][0] * rstd * n1[0] * siluf(bf_lo(zr[u].z)), v1[u][1] * rstd * n1[1] * siluf(bf_hi(zr[u].z)));
            o.w = cvt_pk_bf16(v1[u][2] * rstd * n1[2] * siluf(bf_lo(zr[u].w)), v1[u][3] * rstd * n1[3] * siluf(bf_hi(zr[u].w)));
            *(u32x4*)(p.concat + (size_t)t * DM + g * 512 + h * 128 + i16 * 8) = o;
        }
    }
}

#define XB_TMO      128
#define XB_XCNT(j)  (256  + 64 * (j))
#define XB_XSUB(j)  (1280 + 64 * (j))
#define XB_XGEN(j)  (2304 + 64 * (j))
#define XB_TOP      3328
#define XB_TOPGEN   3392
#define XCD_BAR_WORDS 3456
#define XB_SPIN_CAP (1u << 18)
DI unsigned xb_ld(unsigned* q)              { return __hip_atomic_load(q, __ATOMIC_RELAXED, __HIP_MEMORY_SCOPE_AGENT); }
DI unsigned xb_add(unsigned* q, unsigned v) { return __hip_atomic_fetch_add(q, v, __ATOMIC_RELAXED, __HIP_MEMORY_SCOPE_AGENT); }
DI unsigned xb_xcc_id() { return (unsigned)__builtin_amdgcn_s_getreg((3 << 11) | 20) & 0xFu; }
#define XB_SPIN(cond, bar) do { unsigned _sp = 0; while (cond) { __builtin_amdgcn_s_sleep(1); \
    if ((++_sp & 255u) == 0u) { if (xb_ld(&(bar)[XB_TMO])) break; if (_sp > XB_SPIN_CAP) { atomicAdd(&(bar)[XB_TMO], 1u); break; } } } } while (0)
struct XcdBarrier { unsigned* bar; unsigned x; volatile LAS unsigned* st; };
DI XcdBarrier xcd_barrier_post(unsigned* bar, volatile LAS unsigned* st) {
    XcdBarrier b; b.bar = bar; b.x = xb_xcc_id(); b.st = st;
    if (threadIdx.x == 0) (void)xb_add(&bar[XB_XCNT(b.x)], 1u);
    return b;
}
DI void xcd_barrier_complete(unsigned* bar, unsigned x, unsigned& nloc, unsigned& nx) {
    const unsigned G = gridDim.x * gridDim.y * gridDim.z;
    unsigned sum, cnt, mine, sp = 0u;
    for (;;) {
        sum = 0u; cnt = 0u; mine = 0u;
#pragma unroll
        for (unsigned j = 0; j < 16; ++j) { const unsigned c = xb_ld(&bar[XB_XCNT(j)]); sum += c; cnt += (c > 0u) ? 1u : 0u; mine = (j == x) ? c : mine; }
        if (sum == G) break;
        __builtin_amdgcn_s_sleep(1);
        if ((++sp & 255u) == 0u) { if (xb_ld(&bar[XB_TMO])) break; if (sp > XB_SPIN_CAP) { atomicAdd(&bar[XB_TMO], 1u); break; } }
    }
    nloc = mine > 0u ? mine : 1u; nx = cnt > 0u ? cnt : 1u;
}
DI void xcd_barrier(const XcdBarrier& b) {
    asm volatile("s_waitcnt vmcnt(0)" ::: "memory");
    __syncthreads();
    if (threadIdx.x == 0) {
        unsigned* bar = b.bar;
        __builtin_amdgcn_s_waitcnt(0);
        unsigned nloc = b.st[0], nx = b.st[1];
        if (nloc == 0u) { xcd_barrier_complete(bar, b.x, nloc, nx); b.st[0] = nloc; b.st[1] = nx; }
        const unsigned old = xb_add(&bar[XB_XSUB(b.x)], 1u);
        const unsigned gen = old / nloc;
        if (old + 1u == (gen + 1u) * nloc) {
            __builtin_amdgcn_fence(__ATOMIC_RELEASE, "agent");
            asm volatile("s_waitcnt vmcnt(0)" ::: "memory");
            const unsigned og = xb_add(&bar[XB_TOP], 1u);
            const unsigned tg = og / nx;
            if (og + 1u == (tg + 1u) * nx) xb_add(&bar[XB_TOPGEN], 1u);
            else XB_SPIN(xb_ld(&bar[XB_TOPGEN]) == tg, bar);
            __builtin_amdgcn_fence(__ATOMIC_ACQUIRE, "agent");
            xb_add(&bar[XB_XGEN(b.x)], 1u);
            asm volatile("s_waitcnt vmcnt(0)" ::: "memory");
        } else {
            XB_SPIN(xb_ld(&bar[XB_XGEN(b.x)]) == gen, bar);
            __builtin_amdgcn_fence(__ATOMIC_ACQUIRE, "agent");
            asm volatile("s_waitcnt vmcnt(0)" ::: "memory");
        }
    }
    __syncthreads();
}

__global__ void __launch_bounds__(512, 2) fwd_megakernel(Params p_unused) {
    extern __shared__ __attribute__((aligned(16))) unsigned char shm[];
    cg::grid_group grid = cg::this_grid();
    volatile LAS unsigned* xst = (volatile LAS unsigned*)((LAS unsigned char*)shm + (LDS_BYTES - 32));
    if (threadIdx.x < 2) xst[threadIdx.x] = 0u;
    __syncthreads();
    XcdBarrier xb;
    { const Params p = load_params(); xb = xcd_barrier_post(p.bar, xst); }
    { const Params p = load_params(); phase0(p, (float*)shm); }
    grid.sync();
#if PROBE_PHASE == 10
    { const Params p = load_params(); phase0(p, (float*)shm); }
    xcd_barrier(xb);
#endif
#pragma unroll 1
    for (int l = 0; l < 2; ++l) {
#pragma unroll 1
        for (int rep = 0; rep < (PROBE_PHASE == 1 ? 2 : 1); ++rep) {
        { const Params p = load_params(); phase1(p, l, l == 0 ? p.x : p.x1); }
        xcd_barrier(xb);
        }
#pragma unroll 1
        for (int rep = 0; rep < (PROBE_PHASE == 2 ? 2 : 1); ++rep) {
            const Params p = load_params();
            pg8::StaticOrder S; S.init(TT, NPAD, (int)gridDim.x, get_bid());
            pg8::Gemm g{p.hbuf, p.WinT + (size_t)l * NPAD * 2048, TT, NPAD, 2048};
            EpiProj E{p.proj, p.small};
            pg8::gemm_phase<EpiProj>((LAS unsigned char*)shm, g, S, E);
            xcd_barrier(xb);
        }
#pragma unroll 1
        for (int rep = 0; rep < ((PROBE_PHASE == 3 || (PROBE_PHASE >= 31 && PROBE_PHASE <= 36)) ? 2 : 1); ++rep) {
        { const Params p = load_params(); phase3(p, l, shm, (rep == 0 || PROBE_PHASE == 3) ? 7 : (PROBE_PHASE == 32 ? 2 : (PROBE_PHASE == 33 ? 4 : 1)), (rep == 1 && PROBE_PHASE >= 34) ? PROBE_PHASE - 33 : 0); }
        xcd_barrier(xb);
        }
#pragma unroll 1
        for (int rep = 0; rep < ((PROBE_PHASE == 4 || PROBE_PHASE == 41 || PROBE_PHASE == 42 || PROBE_PHASE == 43) ? 2 : 1); ++rep) {
        { Params p = load_params(); if (PROBE_PHASE == 43 && rep == 1) p.concat = p.hbuf; phase4(p, l + 2 * rep, shm); }
        xcd_barrier(xb);
        }
#pragma unroll 1
        for (int rep = 0; rep < (PROBE_PHASE == 5 ? 2 : 1); ++rep) {
        { const Params p = load_params(); phase5(p, l); }
        xcd_barrier(xb);
        }
#pragma unroll 1
        for (int rep = 0; rep < (PROBE_PHASE == 6 ? 2 : 1); ++rep) {
            const Params p = load_params();
            pg8::StaticOrder S; S.init(TT, DM, (int)gridDim.x, get_bid());
            pg8::Gemm g{p.concat, p.WoutT + (size_t)l * 2048 * 2048, TT, DM, 2048};
            EpiOut E{l == 0 ? p.x : p.x1, l == 0 ? p.x1 : p.out, p.mod + (size_t)l * 4 * 6144 + 4096};
            pg8::gemm_phase<EpiOut>((LAS unsigned char*)shm, g, S, E);
            xcd_barrier(xb);
        }
    }
}

#ifdef MULTI_LAUNCH
__global__ void __launch_bounds__(512, 2) k_p0(Params p) { extern __shared__ __attribute__((aligned(16))) unsigned char shm[]; phase0(p, (float*)shm); }
__global__ void __launch_bounds__(512, 2) k_p1(Params p, int l) { phase1(p, l, l == 0 ? p.x : p.x1); }
__global__ void __launch_bounds__(512, 2) k_p2(Params p, int l) { extern __shared__ __attribute__((aligned(16))) unsigned char shm[];
    pg8::StaticOrder S; S.init(TT, NPAD, (int)gridDim.x, (int)blockIdx.x);
    pg8::Gemm g{p.hbuf, p.WinT + (size_t)l * NPAD * 2048, TT, NPAD, 2048};
    EpiProj E{p.proj, p.small};
    pg8::gemm_phase<EpiProj>((LAS unsigned char*)shm, g, S, E); }
__global__ void __launch_bounds__(512, 2) k_p3a(Params p, int l) { extern __shared__ __attribute__((aligned(16))) unsigned char shm[]; for (int it = blockIdx.x; it < 512; it += gridDim.x) gdn_prep(p, l, it, shm); }
__global__ void __launch_bounds__(512, 2) k_p3b(Params p, int l) { extern __shared__ __attribute__((aligned(16))) unsigned char shm[]; for (int it = blockIdx.x; it < 128; it += gridDim.x) gla_prep(p, l, it, shm); }
__global__ void __launch_bounds__(512, 2) k_p3c(Params p, int l) { extern __shared__ __attribute__((aligned(16))) unsigned char shm[]; for (int it = blockIdx.x; it < 128; it += gridDim.x) diff_prep(p, l, it, shm); }
__global__ void __launch_bounds__(512, 2) k_p4a(Params p, int l) { extern __shared__ __attribute__((aligned(16))) unsigned char shm[]; gdn_chain(p, blockIdx.x, shm); }
__global__ void __launch_bounds__(512, 2) k_p4b(Params p, int l) { extern __shared__ __attribute__((aligned(16))) unsigned char shm[]; gla_chain(p, blockIdx.x, shm); }
__global__ void __launch_bounds__(512, 2) k_p4c(Params p, int l) { extern __shared__ __attribute__((aligned(16))) unsigned char shm[]; attn_item(p, l, blockIdx.x, shm); }
__global__ void __launch_bounds__(512, 2) k_p5(Params p, int l) { phase5(p, l); }
__global__ void __launch_bounds__(512, 2) k_p6(Params p, int l) { extern __shared__ __attribute__((aligned(16))) unsigned char shm[];
    pg8::StaticOrder S; S.init(TT, DM, (int)gridDim.x, (int)blockIdx.x);
    pg8::Gemm g{p.concat, p.WoutT + (size_t)l * 2048 * 2048, TT, DM, 2048};
    EpiOut E{l == 0 ? p.x : p.x1, l == 0 ? p.x1 : p.out, p.mod + (size_t)l * 4 * 6144 + 4096};
    pg8::gemm_phase<EpiOut>((LAS unsigned char*)shm, g, S, E); }
#endif

extern "C" void kernel_launch(void* const* d_in, const int* in_sizes, int n_in, void* d_out, int out_size, void* d_ws, size_t ws_size, hipStream_t stream) {
    static int grid_blocks = 0;
    if (!grid_blocks) {
        int dev = 0, cus = 0, per_cu = 0;
        hipGetDevice(&dev);
        hipDeviceGetAttribute(&cus, hipDeviceAttributeMultiprocessorCount, dev);
        hipFuncSetAttribute((const void*)fwd_megakernel, hipFuncAttributeMaxDynamicSharedMemorySize, LDS_BYTES);
        hipOccupancyMaxActiveBlocksPerMultiprocessor(&per_cu, fwd_megakernel, 512, LDS_BYTES);
        if (per_cu < 1) per_cu = 1;
        if (per_cu > 1) per_cu = 1;
        grid_blocks = cus * per_cu;
    }
    Params p{};
    p.x = (const float*)d_in[0]; p.c = (const float*)d_in[1]; p.pos = (const int*)d_in[2];
    p.norm_w = (const float*)d_in[3]; p.w_ada = (const float*)d_in[4]; p.b_ada = (const float*)d_in[5]; p.w_in = (const float*)d_in[6];
    p.gla_w_lr = (const float*)d_in[7]; p.gla_b_lr = (const float*)d_in[8]; p.gla_norm_w = (const float*)d_in[9];
    p.gdn_conv_w = (const float*)d_in[10]; p.gdn_a_log = (const float*)d_in[11]; p.gdn_dt_bias = (const float*)d_in[12]; p.gdn_norm_w = (const float*)d_in[13];
    p.diff_q_norm_w = (const float*)d_in[14]; p.diff_k_norm_w = (const float*)d_in[15]; p.diff_lambda = (const float*)d_in[16]; p.diff_norm_w = (const float*)d_in[17];
    p.w_out = (const float*)d_in[18];
    p.out = (float*)d_out;
    char* ws = (char*)d_ws; size_t off = 0;
    auto take = [&](size_t bytes) { char* r = ws + off; off += (bytes + 255) & ~(size_t)255; return r; };
    p.WinT = (bf16_t*)take((size_t)2 * NPAD * 2048 * 2);
    p.WoutT = (bf16_t*)take((size_t)2 * 2048 * 2048 * 2);
    p.mod = (float*)take((size_t)2 * 4 * 6144 * 4);
    p.rope = (float*)take((size_t)TT * 128 * 4);
    p.lam = (float*)take(256);
    p.cnt = (unsigned*)take(256);
    p.bar = (unsigned*)take((size_t)XCD_BAR_WORDS * 4);
    p.hbuf = (bf16_t*)take((size_t)TT * DM * 2);
    p.proj = (bf16_t*)take((size_t)TT * NPROJ * 2);
    p.small = (float*)take((size_t)TT * 32 * 4);
    p.x1 = (float*)d_out;
    p.concat = (bf16_t*)take((size_t)TT * DM * 2);
    p.gqe = (bf16_t*)take((size_t)512 * 4096 * 2);
    p.gatt = (bf16_t*)take((size_t)512 * 4096 * 2);
    p.gkdT = (bf16_t*)take((size_t)512 * 4096 * 2);
    p.gvT = (bf16_t*)take((size_t)512 * 8192 * 2);
    p.gdec = (float*)take((size_t)512 * 64 * 4);
    p.ogla = (float*)p.hbuf;
    p.du = (float*)take((size_t)512 * 8192 * 4);
    p.dw = (bf16_t*)take((size_t)512 * 8192 * 2);
    p.dqe = (bf16_t*)take((size_t)512 * 8192 * 2);
    p.dktT = (bf16_t*)take((size_t)512 * 8192 * 2);
    p.dqk = (bf16_t*)take((size_t)512 * 4096 * 2);
    p.dcd = (float*)take((size_t)512 * 4);
    p.ogdn = (float*)p.hbuf + (size_t)TT * 512;
    p.qd = (bf16_t*)take((size_t)32 * SEQ * 128 * 2);
    p.kd = (bf16_t*)take((size_t)32 * SEQ * 128 * 2);
    p.vT = (bf16_t*)take((size_t)16 * 256 * SEQ * 2);
    if (off > ws_size) { fprintf(stderr, "workspace too small: need %zu have %zu\n", off, ws_size); return; }
    (void)hipMemsetAsync(p.bar, 0, (size_t)XCD_BAR_WORDS * 4, stream);
    void* args[] = {&p};
    hipError_t e = hipLaunchCooperativeKernel((void*)fwd_megakernel, dim3(grid_blocks), dim3(512), args, LDS_BYTES, stream);
    if (e != hipSuccess) fprintf(stderr, "cooperative launch failed: %s (grid %d)\n", hipGetErrorString(e), grid_blocks);
}
```

```cpp
#include <hip/hip_runtime.h>
#include <hip/hip_cooperative_groups.h>
#include <cstdio>
namespace cg = cooperative_groups;

#define DI __device__ __forceinline__
#define LAS __attribute__((address_space(3)))
typedef unsigned short bf16_t;
typedef short bf16x8 __attribute__((ext_vector_type(8)));
typedef float f32x4 __attribute__((ext_vector_type(4)));
typedef float f32x2 __attribute__((ext_vector_type(2)));
typedef unsigned u32x4 __attribute__((ext_vector_type(4)));
typedef unsigned u32x2 __attribute__((ext_vector_type(2)));

constexpr int TT = 8192, DM = 2048, SEQ = 2048, DIN = 7704, NPROJ = 7680, NPAD = 7936;
constexpr int LDS_BYTES = 160 * 1024;
#ifndef PROBE_PHASE
#define PROBE_PHASE 0
#endif

struct Params {
    const float *x, *c; const int* pos;
    const float *norm_w, *w_ada, *b_ada, *w_in, *gla_w_lr, *gla_b_lr, *gla_norm_w, *gdn_conv_w, *gdn_a_log, *gdn_dt_bias,
        *gdn_norm_w, *diff_q_norm_w, *diff_k_norm_w, *diff_lambda, *diff_norm_w, *w_out;
    float* out;
    bf16_t *WinT, *WoutT, *hbuf, *proj, *concat;
    float *mod, *rope, *lam, *small, *x1;
    unsigned* cnt; unsigned* bar;
    bf16_t *gqe, *gatt, *gkdT, *gvT; float *gdec, *ogla;
    float *du; bf16_t *dw, *dqe, *dktT, *dqk; float *dcd, *ogdn;
    bf16_t *qd, *kd, *vT;
};

typedef const __attribute__((address_space(4))) unsigned char* KP4;
DI int get_tid() { int t = threadIdx.x; asm volatile("" : "+v"(t)); return t; }
DI int get_bid() { int b = blockIdx.x; asm volatile("" : "+s"(b)); return b; }
DI Params load_params() { KP4 q = (KP4)__builtin_amdgcn_kernarg_segment_ptr(); asm volatile("" : "+s"(q)); Params r; __builtin_memcpy(&r, q, sizeof(Params)); return r; }
typedef __bf16 bf16x2_t __attribute__((ext_vector_type(2)));
DI unsigned cvt_pk_bf16(float lo, float hi) { const f32x2 v = {lo, hi}; const bf16x2_t r = __builtin_convertvector(v, bf16x2_t); return __builtin_bit_cast(unsigned, r); }
DI float bf_lo(unsigned u) { return __uint_as_float(u << 16); }
DI float bf_hi(unsigned u) { return __uint_as_float(u & 0xffff0000u); }
DI float bf2f(bf16_t v) { return __uint_as_float(((unsigned)v) << 16); }
DI float siluf(float x) { return x / (1.f + __expf(-x)); }
DI float xch16_max(float x) { const unsigned u = __float_as_uint(x); const u32x2 r = __builtin_amdgcn_permlane16_swap(u, u, false, false); return fmaxf(__uint_as_float(r[0]), __uint_as_float(r[1])); }
DI float xch32_max(float x) { const unsigned u = __float_as_uint(x); const u32x2 r = __builtin_amdgcn_permlane32_swap(u, u, false, false); return fmaxf(__uint_as_float(r[0]), __uint_as_float(r[1])); }
DI float xch16_add(float x) { const unsigned u = __float_as_uint(x); const u32x2 r = __builtin_amdgcn_permlane16_swap(u, u, false, false); return __uint_as_float(r[0]) + __uint_as_float(r[1]); }
DI float xch32_add(float x) { const unsigned u = __float_as_uint(x); const u32x2 r = __builtin_amdgcn_permlane32_swap(u, u, false, false); return __uint_as_float(r[0]) + __uint_as_float(r[1]); }
template <int CTRL> DI float dpp_f(float x) { return __int_as_float(__builtin_amdgcn_update_dpp(0, __float_as_int(x), CTRL, 0xf, 0xf, false)); }
DI float sum4(float x) { x += dpp_f<0xB1>(x); x += dpp_f<0x4E>(x); return x; }
DI float sum16(float x) { x = sum4(x); x += dpp_f<0x141>(x); x += dpp_f<0x140>(x); return x; }
DI f32x4 mfma16(bf16x8 a, bf16x8 b, f32x4 c) { return __builtin_amdgcn_mfma_f32_16x16x32_bf16(a, b, c, 0, 0, 0); }
DI bf16x8 as_bf16x8(u32x4 v) { return __builtin_bit_cast(bf16x8, v); }

namespace pg8 {
constexpr int BM = 256, BK = 64, HALF = 128, HTB = HALF * BK * 2, STAGE_BYTES = 8 * HTB, NXCD = 8, WGM = 8;
DI int lds_byte(int r, int c) { const int st = (r >> 4) * 2 + (c >> 5), rr = r & 15, cc = c & 31, ob = rr * 64 + cc * 2; return st * 1024 + (ob ^ (((ob >> 9) & 1) << 5)); }
DI void stage_rc(int b, int& R, int& C) { const int st = b / 1024, sb = b % 1024, swz = sb ^ (((sb >> 9) & 1) << 5); R = (st >> 1) * 16 + swz / 64; C = (st & 1) * 32 + (swz % 64) / 2; }
DI int perm32(int rho) { const int n = rho >> 4, i = rho & 15; return 8 * (i >> 2) + 4 * n + (i & 3); }
struct Unit { int pm, pn; };
struct Gemm { const bf16_t* A; const bf16_t* Bt; int M, N, K; };
struct StaticOrder {
    int nM, nN, nwg, G, c;
    DI void init(int M, int N, int G_, int c_) { nM = M / BM; nN = N / BM; nwg = nM * nN; G = G_; c = c_; }
    DI bool next(int i, Unit& u) const {
        const long L = (long)i * G + c; if (L >= nwg) return false;
        int wgid = (int)L; { const int q = nwg / NXCD, r = nwg % NXCD, xcd = wgid % NXCD, off = wgid / NXCD; wgid = (xcd < r ? xcd * (q + 1) : r * (q + 1) + (xcd - r) * q) + off; }
        const int nig = WGM * nN, gid = wgid / nig, fm = gid * WGM, gsz = (nM - fm) < WGM ? (nM - fm) : WGM;
        u.pm = fm + ((wgid % nig) % gsz); u.pn = (wgid % nig) / gsz; return true;
    }
};

template <class Epi>
DI void gemm_phase(LAS unsigned char* lds, const Gemm g, const StaticOrder& S, const Epi& E) {
    const int tid = get_tid(), wid = __builtin_amdgcn_readfirstlane(tid >> 6), lane = tid & 63, wr = wid >> 2, wc = wid & 3, fr = lane & 15, fq = lane >> 4;
    const int K = g.K, nt = K / BK;
    unsigned voffA[2], voffB[2];
#pragma unroll
    for (int i = 0; i < 2; ++i) { int R, C; stage_rc(tid * 16 + i * 8192, R, C); const int Rb = Epi::PERM ? ((R & ~31) + perm32(R & 31)) : R;
        voffA[i] = (unsigned)(R * K + C) * 2u; voffB[i] = (unsigned)(Rb * K + C) * 2u; }
    const size_t kstep = (size_t)(BK * 2);
    const size_t hstep = (size_t)HALF * K * 2;
    const size_t tstep = 2 * hstep;
    const unsigned ldsw = (unsigned)wid * 1024u;
    const int aoff = lds_byte(wr * 64 + fr, fq * 8), boff = lds_byte(wc * 32 + fr, fq * 8);
#define PG8_SA(b, h) (((b) * 2 + (h)) * HTB)
#define PG8_SB(b, h) ((4 + (b) * 2 + (h)) * HTB)
#define PG8_STAGE(bufoff, gbase, voff) do { _Pragma("unroll") for (int _i = 0; _i < 2; ++_i) \
        __builtin_amdgcn_global_load_lds((const unsigned*)((const char*)(gbase) + (voff)[_i]), (LAS unsigned*)(lds + (bufoff) + ldsw + _i * 8192), 16, 0, 0); } while (0)
#define PG8_LDA(dst, b, h) do { _Pragma("unroll") for (int m = 0; m < 4; ++m) _Pragma("unroll") for (int k = 0; k < 2; ++k) dst[m][k] = *(const LAS bf16x8*)(lds + PG8_SA(b, h) + aoff + m * 2048 + k * 1024); } while (0)
#define PG8_LDB(dst, b, h) do { _Pragma("unroll") for (int n = 0; n < 2; ++n) _Pragma("unroll") for (int k = 0; k < 2; ++k) dst[n][k] = *(const LAS bf16x8*)(lds + PG8_SB(b, h) + boff + n * 2048 + k * 1024); } while (0)
#define PG8_MMA(ai, bj, At, Bt) do { __builtin_amdgcn_s_setprio(1); _Pragma("unroll") for (int m = 0; m < 4; ++m) _Pragma("unroll") for (int n = 0; n < 2; ++n) _Pragma("unroll") for (int k = 0; k < 2; ++k) \
        acc[ai][bj][m][n] = __builtin_amdgcn_mfma_f32_16x16x32_bf16(Bt[n][k], At[m][k], acc[ai][bj][m][n], 0, 0, 0); __builtin_amdgcn_s_setprio(0); } while (0)
#define PG8_WAIT_V(n) asm volatile("s_waitcnt vmcnt(" #n ")" ::: "memory")
#define PG8_WAIT_L(n) asm volatile("s_waitcnt lgkmcnt(" #n ")" ::: "memory")
#define PG8_BAR __builtin_amdgcn_s_barrier()
#define PG8_SCHED __builtin_amdgcn_sched_barrier(0)
    Unit cur, nxt; int ui = 0;
    if (!S.next(0, cur)) return;
    f32x4 acc[2][2][4][2];
#pragma unroll
    for (int a = 0; a < 2; ++a)
#pragma unroll
        for (int b = 0; b < 2; ++b)
#pragma unroll
            for (int m = 0; m < 4; ++m)
#pragma unroll
                for (int n = 0; n < 2; ++n) acc[a][b][m][n] = (f32x4){0.f, 0.f, 0.f, 0.f};
    bf16x8 At[4][2], B0[2][2], B1[2][2];
    const char* cA = (const char*)g.A + (size_t)cur.pm * tstep; const char* cB = (const char*)g.Bt + (size_t)cur.pn * tstep;
    PG8_STAGE(PG8_SB(0, 0), cB, voffB); PG8_STAGE(PG8_SA(0, 0), cA, voffA); PG8_STAGE(PG8_SB(0, 1), cB + hstep, voffB); PG8_STAGE(PG8_SA(0, 1), cA + hstep, voffA);
    if (wr == 1) PG8_BAR;
    PG8_WAIT_V(4); PG8_BAR;
    PG8_STAGE(PG8_SB(1, 0), cB + kstep, voffB); PG8_STAGE(PG8_SA(1, 0), cA + kstep, voffA); PG8_STAGE(PG8_SB(1, 1), cB + hstep + kstep, voffB);
    PG8_WAIT_V(6); PG8_BAR;
    for (;;) {
        const bool has_next = S.next(ui + 1, nxt);
        const char* nA = has_next ? (const char*)g.A + (size_t)nxt.pm * tstep : cA; const char* nB = has_next ? (const char*)g.Bt + (size_t)nxt.pn * tstep : cB;
        for (int t = 0; t < nt; t += 2) {
            const bool last = (t == nt - 2);
            const char* a1 = cA + (size_t)(t + 1) * kstep;
            const char* a2 = last ? nA : cA + (size_t)(t + 2) * kstep; const char* b2 = last ? nB : cB + (size_t)(t + 2) * kstep;
            const char* a3 = a2 + kstep; const char* b3 = b2 + kstep;
            PG8_LDB(B0, 0, 0); PG8_SCHED; PG8_LDA(At, 0, 0); PG8_STAGE(PG8_SA(1, 1), a1 + hstep, voffA);
            PG8_WAIT_L(8); PG8_BAR; PG8_WAIT_L(0); PG8_MMA(0, 0, At, B0); PG8_BAR; PG8_SCHED;
            PG8_LDB(B1, 0, 1); PG8_STAGE(PG8_SB(0, 0), b2, voffB);
            PG8_BAR; PG8_WAIT_L(0); PG8_MMA(0, 1, At, B1); PG8_BAR;
            PG8_LDA(At, 0, 1); PG8_STAGE(PG8_SA(0, 0), a2, voffA);
            PG8_BAR; PG8_WAIT_L(0); PG8_MMA(1, 0, At, B0); PG8_BAR; PG8_SCHED;
            PG8_STAGE(PG8_SB(0, 1), b2 + hstep, voffB);
            PG8_WAIT_V(6); PG8_BAR; PG8_MMA(1, 1, At, B1); PG8_BAR;
            PG8_LDB(B0, 1, 0); PG8_SCHED; PG8_LDA(At, 1, 0); PG8_STAGE(PG8_SA(0, 1), a2 + hstep, voffA);
            PG8_WAIT_L(8); PG8_BAR; PG8_WAIT_L(0); PG8_MMA(0, 0, At, B0); PG8_BAR; PG8_SCHED;
            PG8_LDB(B1, 1, 1); PG8_STAGE(PG8_SB(1, 0), b3, voffB);
            PG8_BAR; PG8_WAIT_L(0); PG8_MMA(0, 1, At, B1); PG8_BAR;
            PG8_LDA(At, 1, 1); PG8_STAGE(PG8_SA(1, 0), a3, voffA);
            PG8_BAR; PG8_WAIT_L(0); PG8_MMA(1, 0, At, B0); PG8_BAR; PG8_SCHED;
            PG8_STAGE(PG8_SB(1, 1), b3 + hstep, voffB);
            PG8_WAIT_V(6); PG8_BAR; PG8_MMA(1, 1, At, B1); PG8_BAR;
        }
        E(acc, cur, wr, wc, fr, fq);
        if (!has_next) break;
#pragma unroll
        for (int a = 0; a < 2; ++a)
#pragma unroll
            for (int b = 0; b < 2; ++b)
#pragma unroll
                for (int m = 0; m < 4; ++m)
#pragma unroll
                    for (int n = 0; n < 2; ++n) acc[a][b][m][n] = (f32x4){0.f, 0.f, 0.f, 0.f};
        cur = nxt; cA = nA; cB = nB; ++ui;
    }
    PG8_WAIT_V(0);
    if (wr == 0) PG8_BAR;
    PG8_BAR;
#undef PG8_SA
#undef PG8_SB
#undef PG8_STAGE
#undef PG8_LDA
#undef PG8_LDB
#undef PG8_MMA
#undef PG8_WAIT_V
#undef PG8_WAIT_L
#undef PG8_BAR
#undef PG8_SCHED
}
}

struct EpiProj {
    static constexpr bool PERM = true;
    bf16_t* proj; float* small;
    DI void operator()(const f32x4 (&acc)[2][2][4][2], const pg8::Unit& u, int wr, int wc, int fr, int fq) const {
        const int row0 = u.pm * 256 + wr * 64 + fr;
        if (u.pn < 30) {
            const int col0 = u.pn * 256 + wc * 32 + 8 * fq;
#pragma unroll
            for (int ai = 0; ai < 2; ++ai)
#pragma unroll
                for (int m = 0; m < 4; ++m) {
                    bf16_t* rowp = proj + (size_t)(row0 + ai * 128 + m * 16) * NPROJ + col0;
#pragma unroll
                    for (int bj = 0; bj < 2; ++bj) {
                        const f32x4 v0 = acc[ai][bj][m][0], v1 = acc[ai][bj][m][1];
                        u32x4 w; w.x = cvt_pk_bf16(v0[0], v0[1]); w.y = cvt_pk_bf16(v0[2], v0[3]); w.z = cvt_pk_bf16(v1[0], v1[1]); w.w = cvt_pk_bf16(v1[2], v1[3]);
                        *(u32x4*)(rowp + bj * 128) = w;
                    }
                }
        } else if (wc == 0) {
#pragma unroll
            for (int ai = 0; ai < 2; ++ai)
#pragma unroll
                for (int m = 0; m < 4; ++m) {
                    float* rowp = small + (size_t)(row0 + ai * 128 + m * 16) * 32 + 8 * fq;
                    *(f32x4*)(rowp) = acc[ai][0][m][0]; *(f32x4*)(rowp + 4) = acc[ai][0][m][1];
                }
        }
    }
};
struct EpiOut {
    static constexpr bool PERM = false;
    const float* xin; float* xout; const float* gate;
    DI void operator()(const f32x4 (&acc)[2][2][4][2], const pg8::Unit& u, int wr, int wc, int fr, int fq) const {
        const int row0 = u.pm * 256 + wr * 64 + fr, col0 = u.pn * 256 + wc * 32 + 4 * fq;
        const int b = (u.pm * 256) >> 11;
        f32x4 g[2][2];
#pragma unroll
        for (int bj = 0; bj < 2; ++bj)
#pragma unroll
            for (int n = 0; n < 2; ++n) g[bj][n] = *(const f32x4*)(gate + b * 6144 + col0 + bj * 128 + n * 16);
#pragma unroll
        for (int ai = 0; ai < 2; ++ai)
#pragma unroll
            for (int mh = 0; mh < 2; ++mh) {
                f32x4 xv[2][2][2];
#pragma unroll
                for (int mm = 0; mm < 2; ++mm)
#pragma unroll
                    for (int bj = 0; bj < 2; ++bj)
#pragma unroll
                        for (int n = 0; n < 2; ++n)
                            xv[mm][bj][n] = *(const f32x4*)(xin + (size_t)(row0 + ai * 128 + (2 * mh + mm) * 16) * DM + col0 + bj * 128 + n * 16);
#pragma unroll
                for (int mm = 0; mm < 2; ++mm)
#pragma unroll
                    for (int bj = 0; bj < 2; ++bj)
#pragma unroll
                        for (int n = 0; n < 2; ++n)
                            *(f32x4*)(xout + (size_t)(row0 + ai * 128 + (2 * mh + mm) * 16) * DM + col0 + bj * 128 + n * 16) = xv[mm][bj][n] + g[bj][n] * acc[ai][bj][2 * mh + mm][n];
            }
    }
};

DI int orig_col(int j) {
    if (j < 1024) return j;
    if (j < 3072) return j + 16;
    if (j < 7680) return j + 24;
    if (j < 7696) return 1024 + (j - 7680);
    if (j < 7704) return 3088 + (j - 7696);
    return -1;
}
DI void transpose_tile(const float* src, int ldsrc, bf16_t* dst, int n0, int k0, bool remap, float* tile) {
    const int tid = get_tid(), nn = tid & 63, kb = tid >> 6;
    const int n = n0 + nn, oc = remap ? orig_col(n) : n;
    float v[32];
#pragma unroll
    for (int i = 0; i < 32; ++i) v[i] = oc >= 0 ? __builtin_nontemporal_load(src + (size_t)(k0 + kb + 8 * i) * ldsrc + oc) : 0.f;
#pragma unroll
    for (int i = 0; i < 32; ++i) tile[(kb + 8 * i) * 65 + nn] = v[i];
    __syncthreads();
    const int r = tid >> 3, seg = tid & 7;
#pragma unroll
    for (int half = 0; half < 2; ++half) {
        unsigned pk[8];
#pragma unroll
        for (int j = 0; j < 8; ++j) pk[j] = cvt_pk_bf16(tile[(half * 128 + seg * 16 + 2 * j) * 65 + r], tile[(half * 128 + seg * 16 + 2 * j + 1) * 65 + r]);
        u32x4* d = (u32x4*)(dst + (size_t)(n0 + r) * 2048 + k0 + half * 128 + seg * 16);
        d[0] = (u32x4){pk[0], pk[1], pk[2], pk[3]}; d[1] = (u32x4){pk[4], pk[5], pk[6], pk[7]};
    }
    __syncthreads();
}
DI void adaln_item(const Params& p, int l, int cgp, float* lds) {
    const int tid = get_tid(), w = tid >> 6, lane = tid & 63;
    for (int i = tid; i < 8192; i += 512) { const float cv = p.c[i]; lds[i] = cv / (1.f + expf(-cv)); }
    __syncthreads();
    const int col = cgp * 64 + lane;
    const float* wp = p.w_ada + (size_t)l * 2048 * 6144 + col;
    float a0 = 0.f, a1 = 0.f, a2 = 0.f, a3 = 0.f;
    for (int k = w * 256; k < w * 256 + 256; k += 64) {
        float wv[64];
#pragma unroll
        for (int j = 0; j < 64; ++j) wv[j] = __builtin_nontemporal_load(wp + (size_t)(k + j) * 6144);
#pragma unroll
        for (int j = 0; j < 64; ++j) { a0 += lds[k + j] * wv[j]; a1 += lds[2048 + k + j] * wv[j]; a2 += lds[4096 + k + j] * wv[j]; a3 += lds[6144 + k + j] * wv[j]; }
    }
    float* red = lds + 8192;
    red[(w * 4 + 0) * 64 + lane] = a0; red[(w * 4 + 1) * 64 + lane] = a1; red[(w * 4 + 2) * 64 + lane] = a2; red[(w * 4 + 3) * 64 + lane] = a3;
    __syncthreads();
    if (tid < 256) {
        const int b = tid >> 6; float s = 0.f;
#pragma unroll
        for (int ww = 0; ww < 8; ++ww) s += red[(ww * 4 + b) * 64 + lane];
        p.mod[(size_t)(l * 4 + b) * 6144 + col] = s + p.b_ada[l * 6144 + col];
    }
    __syncthreads();
}
DI void phase0(const Params& p, float* lds) {
    const int tid = get_tid();
    const int bid = get_bid();
    if (bid == 0 && tid < 64) p.cnt[tid] = 0u;
    if (bid == 1 && tid < 2) {
        const float* lv = p.diff_lambda + tid * 512; float s1 = 0.f, s2 = 0.f;
        for (int i = 0; i < 128; ++i) { s1 += lv[i] * lv[128 + i]; s2 += lv[256 + i] * lv[384 + i]; }
        const float lam_init = 0.8f - 0.6f * expf(-0.3f * (float)tid);
        p.lam[tid] = expf(s1) - expf(s2) + lam_init;
    }
    constexpr int N_ADA = 192, N_ROPE = 128, N_WIN = 124 * 8, N_WOUT = 32 * 8;
    constexpr int N_ITEMS = N_ADA + N_ROPE + 2 * (N_WIN + N_WOUT);
    for (int it = bid; it < N_ITEMS; it += gridDim.x) {
        if (it < N_ADA) { adaln_item(p, it / 96, it % 96, lds); }
        else if (it < N_ADA + N_ROPE) {
            const int t0 = (it - N_ADA) * 64;
            for (int e = tid; e < 64 * 64; e += 512) {
                const int t = t0 + (e >> 6), i = e & 63;
                const float inv = powf(10000.0f, -(float)i / 64.0f);
                const float ang = (float)p.pos[t] * inv;
                p.rope[(size_t)t * 128 + i] = cosf(ang); p.rope[(size_t)t * 128 + 64 + i] = sinf(ang);
            }
        } else {
            int j = it - N_ADA - N_ROPE; const int l = j / (N_WIN + N_WOUT); j -= l * (N_WIN + N_WOUT);
            if (j < N_WIN) transpose_tile(p.w_in + (size_t)l * 2048 * DIN, DIN, p.WinT + (size_t)l * NPAD * 2048, (j >> 3) * 64, (j & 7) * 256, true, lds);
            else { j -= N_WIN; transpose_tile(p.w_out + (size_t)l * 2048 * 2048, 2048, p.WoutT + (size_t)l * 2048 * 2048, (j >> 3) * 64, (j & 7) * 256, false, lds); }
        }
    }
}

DI void phase1(const Params& p, int l, const float* xin) {
    const int tid = get_tid(), w = tid >> 6, lane = tid & 63;
    const int nwav = gridDim.x * 8;
    for (int q = get_bid() * 8 + w; q < TT / 2; q += nwav) {
        const int b = q >> 10, r0 = b * 2048 + (q & 1023);
        const float* md = p.mod + (size_t)(l * 4 + b) * 6144;
        f32x4 v[2][8], nw[8], sh[8], sc[8];
#pragma unroll
        for (int u = 0; u < 2; ++u)
#pragma unroll
            for (int i = 0; i < 8; ++i) v[u][i] = *(const f32x4*)(xin + (size_t)(r0 + u * 1024) * DM + i * 256 + lane * 4);
#pragma unroll
        for (int i = 0; i < 8; ++i) {
            const int col = i * 256 + lane * 4;
            nw[i] = *(const f32x4*)(p.norm_w + l * 2048 + col); sh[i] = *(const f32x4*)(md + col); sc[i] = *(const f32x4*)(md + 2048 + col);
        }
        float ss[2] = {0.f, 0.f};
#pragma unroll
        for (int u = 0; u < 2; ++u) {
#pragma unroll
            for (int i = 0; i < 8; ++i) ss[u] += v[u][i][0] * v[u][i][0] + v[u][i][1] * v[u][i][1] + v[u][i][2] * v[u][i][2] + v[u][i][3] * v[u][i][3];
            ss[u] = sum16(ss[u]); ss[u] = xch16_add(ss[u]); ss[u] = xch32_add(ss[u]);
        }
#pragma unroll
        for (int u = 0; u < 2; ++u) {
            const float rstd = rsqrtf(ss[u] * (1.f / 2048.f) + 1e-6f);
#pragma unroll
            for (int i = 0; i < 8; ++i) {
                const f32x4 y = v[u][i] * rstd * nw[i] * (1.f + sc[i]) + sh[i];
                u32x2 o; o.x = cvt_pk_bf16(y[0], y[1]); o.y = cvt_pk_bf16(y[2], y[3]);
                *(u32x2*)(p.hbuf + (size_t)(r0 + u * 1024) * DM + i * 256 + lane * 4) = o;
            }
        }
    }
}

DI void gdn_prep(const Params& p, int l, int ci, unsigned char* lds, int stop) {
    const int tid = get_tid(), w = tid >> 6, lane = tid & 63, fr = lane & 15, q4 = lane >> 4;
    const int n = ci & 31, h = (ci >> 5) & 3, b = ci >> 7;
    const int t0 = b * SEQ + n * 64;
    constexpr int FS = 129;
    float* gcs = (float*)lds;
    float* bet = gcs + 64;
    float* rn = bet + 64;
    float* eg = rn + 128;
    float* egl = eg + 64;
    float* qf = egl + 64;
    float* kf = qf + 64 * FS;
    float* vf = kf + 64 * FS;
    float* Lm = vf + 64 * FS;
    bf16_t* qb = (bf16_t*)(Lm + 64 * 64);
    bf16_t* kb = qb + 64 * 136;
    bf16_t* raw = (bf16_t*)Lm;
    float cwt[3][4];
#pragma unroll
    for (int r = 0; r < 3; ++r) {
        const int chn = (tid + r * 512) % 384, seg = chn >> 7, d = chn & 127;
        const float* cw = p.gdn_conv_w + (size_t)l * 4 * 1536 + seg * 512 + h * 128 + d;
        cwt[r][0] = cw[0]; cwt[r][1] = cw[1536]; cwt[r][2] = cw[2 * 1536]; cwt[r][3] = cw[3 * 1536];
    }
    {
        u32x4 sv[7];
#pragma unroll
        for (int i = 0; i < 7; ++i) {
            const int e = tid + i * 512;
            const int row = e / 48, rem = e - row * 48, seg = rem >> 4, ch = rem & 15;
            sv[i] = (u32x4){0u, 0u, 0u, 0u};
            if (e < 67 * 48 && (n > 0 || row >= 3)) sv[i] = __builtin_nontemporal_load((const u32x4*)(p.proj + (size_t)(t0 - 3 + row) * NPROJ + 1536 + seg * 512 + h * 128 + ch * 8));
        }
#pragma unroll
        for (int i = 0; i < 7; ++i) {
            const int e = tid + i * 512;
            const int row = e / 48, rem = e - row * 48, seg = rem >> 4, ch = rem & 15;
            if (e < 67 * 48) *(u32x4*)(raw + row * 384 + seg * 128 + ch * 8) = sv[i];
        }
    }
    if (tid < 64) {
        const int c = tid;
        const float da = p.small[(size_t)(t0 + c) * 32 + 16 + h], db = p.small[(size_t)(t0 + c) * 32 + 20 + h];
        const float xx = da + p.gdn_dt_bias[l * 4 + h];
        const float sp = xx > 20.f ? xx : log1pf(expf(xx));
        gcs[c] = -expf(p.gdn_a_log[l * 4 + h]) * sp;
        bet[c] = 1.f / (1.f + expf(-db));
    }
    __syncthreads();
#pragma unroll
    for (int r = 0; r < 3; ++r) {
        const int task = tid + r * 512;
        const int chn = task % 384, qt = task / 384;
        const int seg = chn >> 7, d = chn & 127;
        const float w0 = cwt[r][0], w1 = cwt[r][1], w2 = cwt[r][2], w3 = cwt[r][3];
        const bf16_t* rp = raw + (qt * 16) * 384 + seg * 128 + d;
        float xs[19];
#pragma unroll
        for (int c = 0; c < 19; ++c) xs[c] = bf2f(rp[c * 384]);
        float* dst = (seg == 0 ? qf : (seg == 1 ? kf : vf)) + (qt * 16) * FS + d;
#pragma unroll
        for (int c = 0; c < 16; ++c) {
            const float a = w0 * xs[c] + w1 * xs[c + 1] + w2 * xs[c + 2] + w3 * xs[c + 3];
            dst[c * FS] = a * __builtin_amdgcn_rcpf(1.f + __expf(-a));
        }
    }
    __syncthreads();
    if (stop == 1) return;
    {
        const int row = tid >> 2, sub = tid & 3;
        const float* src = (row < 64 ? qf + row * FS : kf + (row - 64) * FS);
        float s = 0.f;
        for (int i = 0; i < 32; ++i) { const float v = src[sub + 4 * i]; s += v * v; }
        s = sum4(s);
        if (sub == 0) rn[row] = rsqrtf(s + 1e-6f);
    }
    float gsum = 0.f;
    if (tid < 64) {
        gsum = gcs[tid];
#pragma unroll
        for (int o = 1; o < 64; o <<= 1) { const float t = __shfl_up(gsum, o); if (lane >= o) gsum += t; }
    }
    __syncthreads();
    if (tid < 64) gcs[tid] = gsum;
    { const float glast = __shfl(gsum, 63); if (tid < 64) { eg[tid] = __expf(gsum); egl[tid] = __expf(glast - gsum); } }
    for (int e = tid; e < 64 * 128; e += 512) {
        const int c = e >> 7, d = e & 127;
        const float qv = qf[c * FS + d] * rn[c] * 0.08838834764831845f, kv = kf[c * FS + d] * rn[64 + c];
        qf[c * FS + d] = qv; kf[c * FS + d] = kv;
        qb[c * 136 + d] = (bf16_t)(cvt_pk_bf16(qv, 0.f) & 0xffffu); kb[c * 136 + d] = (bf16_t)(cvt_pk_bf16(kv, 0.f) & 0xffffu);
    }
    __syncthreads();
    {
        const int ct = w >> 1;
        const int c = ct * 16 + fr;
        const float gc_c = gcs[c], be_c = bet[c];
#pragma unroll
        for (int i = 0; i < 2; ++i) {
            const int st = (w & 1) * 2 + i;
            f32x4 akk = {0.f, 0.f, 0.f, 0.f}, aqk = {0.f, 0.f, 0.f, 0.f};
            if (st <= ct) {
#pragma unroll
                for (int ks = 0; ks < 4; ++ks) {
                    const bf16x8 ak = *(const bf16x8*)(kb + (st * 16 + fr) * 136 + ks * 32 + q4 * 8);
                    const bf16x8 bk = *(const bf16x8*)(kb + (ct * 16 + fr) * 136 + ks * 32 + q4 * 8);
                    const bf16x8 bq = *(const bf16x8*)(qb + (ct * 16 + fr) * 136 + ks * 32 + q4 * 8);
                    akk = mfma16(ak, bk, akk); aqk = mfma16(ak, bq, aqk);
                }
            }
            f32x4 lv, qv;
#pragma unroll
            for (int r = 0; r < 4; ++r) {
                const int s = st * 16 + q4 * 4 + r;
                const float dec = (s <= c) ? __expf(gc_c - gcs[s]) : 0.f;
                lv[r] = (s < c) ? be_c * akk[r] * dec : 0.f;
                qv[r] = aqk[r] * dec;
            }
            *(f32x4*)(Lm + c * 64 + st * 16 + q4 * 4) = lv;
            u32x2 o; o.x = cvt_pk_bf16(qv[0], qv[1]); o.y = cvt_pk_bf16(qv[2], qv[3]);
            *(u32x2*)(p.dqk + (size_t)ci * 4096 + c * 64 + st * 16 + q4 * 4) = o;
        }
    }
    __syncthreads();
    if (stop == 2) { __syncthreads(); return; }
    if (tid >= 256) {
        const int t2 = tid - 256;
#pragma unroll
        for (int i = 0; i < 4; ++i) {
            const int e = t2 + i * 256; const int c = e >> 4, d = (e & 15) * 8; const float egc = eg[c];
            const u32x4 r = *(const u32x4*)(qb + c * 136 + d);
            u32x4 o; o.x = cvt_pk_bf16(bf_lo(r.x) * egc, bf_hi(r.x) * egc); o.y = cvt_pk_bf16(bf_lo(r.y) * egc, bf_hi(r.y) * egc);
            o.z = cvt_pk_bf16(bf_lo(r.z) * egc, bf_hi(r.z) * egc); o.w = cvt_pk_bf16(bf_lo(r.w) * egc, bf_hi(r.w) * egc);
            *(u32x4*)(p.dqe + (size_t)ci * 8192 + c * 128 + d) = o;
        }
#pragma unroll
        for (int i = 0; i < 4; ++i) {
            const int e = t2 + i * 256; const int d = e & 127, c = (e >> 7) * 8;
            float kv[8];
#pragma unroll
            for (int j = 0; j < 8; ++j) kv[j] = bf2f(kb[(c + j) * 136 + d]) * egl[c + j];
            u32x4 o; o.x = cvt_pk_bf16(kv[0], kv[1]); o.y = cvt_pk_bf16(kv[2], kv[3]); o.z = cvt_pk_bf16(kv[4], kv[5]); o.w = cvt_pk_bf16(kv[6], kv[7]);
            *(u32x4*)(p.dktT + (size_t)ci * 8192 + d * 64 + c) = o;
        }
        if (t2 == 0) p.dcd[ci] = eg[63];
    } else if (stop != 3) {
        const int j = tid & 127; const bool isw = tid >= 128;
        float* X = (isw ? kf : vf) + j;
        int zoff; asm volatile("v_mov_b32 %0, 0" : "=v"(zoff));
        const float* Lz = Lm + zoff;
#pragma unroll 1
        for (int rb = 0; rb < 4; ++rb) {
            float a[16];
#pragma unroll
            for (int r = 0; r < 16; ++r) { const int i = rb * 16 + r; float v = X[i * FS] * bet[i]; if (isw) v *= eg[i]; a[r] = v; }
#pragma unroll 1
            for (int j4 = 0; j4 < rb * 4; ++j4) {
                const float x0 = X[(j4 * 4 + 0) * FS], x1 = X[(j4 * 4 + 1) * FS], x2 = X[(j4 * 4 + 2) * FS], x3 = X[(j4 * 4 + 3) * FS];
#pragma unroll
                for (int r = 0; r < 16; ++r) {
                    const f32x4 lv = *(const f32x4*)(Lz + (rb * 16 + r) * 64 + j4 * 4);
                    a[r] -= lv[0] * x0; a[r] -= lv[1] * x1; a[r] -= lv[2] * x2; a[r] -= lv[3] * x3;
                }
            }
#pragma unroll
            for (int r = 1; r < 16; ++r) {
#pragma unroll
                for (int r2 = 0; r2 < r; ++r2) a[r] -= Lz[(rb * 16 + r) * 64 + rb * 16 + r2] * a[r2];
            }
#pragma unroll
            for (int r = 0; r < 16; ++r) X[(rb * 16 + r) * FS] = a[r];
            if (!isw) {
#pragma unroll
                for (int r = 0; r < 16; ++r) p.du[(size_t)ci * 8192 + (rb * 16 + r) * 128 + j] = a[r];
            } else {
#pragma unroll
                for (int r = 0; r < 16; ++r) p.dw[(size_t)ci * 8192 + (rb * 16 + r) * 128 + j] = (bf16_t)(cvt_pk_bf16(a[r], 0.f) & 0xffffu);
            }
        }
    }
    __syncthreads();
}

DI void gla_prep(const Params& p, int l, int bn, unsigned char* lds) {
    const int tid = get_tid(), w = tid >> 6, lane = tid & 63, fr = lane & 15, q4 = lane >> 4;
    const int n = bn & 31, b = bn >> 5;
    const int t0 = b * SEQ + n * 64;
    float* glr = (float*)lds;
    float* bcum = glr + 64 * 16;
    bf16_t* qe_s = (bf16_t*)(bcum + 64 * 256);
    bf16_t* ke_s = qe_s + 64 * 72;
    bf16_t* kdT_s = ke_s + 64 * 72;
    bf16_t* vT_s = kdT_s + 64 * 72;
    u32x4 qr4[4], kr4[4], va4[4], vb4[4];
    {
        const int c = tid >> 3, ds = (tid & 7) * 8, dv0 = (tid & 7) * 16;
        const bf16_t* rowp = p.proj + (size_t)(t0 + c) * NPROJ;
#pragma unroll
        for (int h = 0; h < 4; ++h) {
            qr4[h] = __builtin_nontemporal_load((const u32x4*)(rowp + h * 64 + ds)); kr4[h] = __builtin_nontemporal_load((const u32x4*)(rowp + 256 + h * 64 + ds));
            va4[h] = __builtin_nontemporal_load((const u32x4*)(rowp + 512 + h * 128 + dv0)); vb4[h] = __builtin_nontemporal_load((const u32x4*)(rowp + 512 + h * 128 + dv0 + 8));
        }
    }
    float wl[16]; float bl;
#pragma unroll
    for (int r = 0; r < 16; ++r) wl[r] = p.gla_w_lr[(size_t)l * 16 * 256 + r * 256 + (tid & 255)];
    bl = p.gla_b_lr[l * 256 + (tid & 255)];
    if (tid < 256) { const int c = tid >> 2, r4 = (tid & 3) * 4; *(f32x4*)(glr + c * 16 + r4) = *(const f32x4*)(p.small + (size_t)(t0 + c) * 32 + r4); }
    __syncthreads();
    {
        const int col = tid & 255, c0 = (tid >> 8) * 32;
        float run = 0.f;
#pragma unroll 4
        for (int c = c0; c < c0 + 32; ++c) {
            float z = bl;
#pragma unroll
            for (int r = 0; r < 16; ++r) z += glr[c * 16 + r] * wl[r];
            const float la = (fminf(z, 0.f) - __logf(1.f + __expf(-fabsf(z)))) * (1.f / 16.f);
            run += la; bcum[c * 256 + col] = run;
        }
    }
    __syncthreads();
#pragma unroll
    for (int h = 0; h < 4; ++h) {
        const int ci = (b * 4 + h) * 32 + n;
        bf16_t* qe_h = qe_s + (h & 1) * 23040;
        bf16_t* ke_h = qe_h + 64 * 72;
        bf16_t* kdT_h = ke_h + 64 * 72;
        bf16_t* vT_h = kdT_h + 64 * 72;
        {
            const int c = tid >> 3, ds = (tid & 7) * 8, sw = (tid & 7) * 8;
            const u32x4 qr = qr4[h];
            const u32x4 kr = kr4[h];
            float qv[8], kv[8], bv[8], bl8[8];
#pragma unroll
            for (int j = 0; j < 4; ++j) { qv[2 * j] = bf_lo(qr[j]); qv[2 * j + 1] = bf_hi(qr[j]); kv[2 * j] = bf_lo(kr[j]); kv[2 * j + 1] = bf_hi(kr[j]); }
#pragma unroll
            for (int j = 0; j < 8; ++j) {
                const float t1 = bcum[31 * 256 + h * 64 + ds + j];
                bv[j] = bcum[c * 256 + h * 64 + ds + j] + (c >= 32 ? t1 : 0.f);
                bl8[j] = bcum[63 * 256 + h * 64 + ds + j] + t1;
            }
            u32x4 qo, ko;
#pragma unroll
            for (int j = 0; j < 4; ++j) {
                qo[j] = cvt_pk_bf16(qv[2 * j] * 0.125f * __expf(bv[2 * j]), qv[2 * j + 1] * 0.125f * __expf(bv[2 * j + 1]));
                ko[j] = cvt_pk_bf16(kv[2 * j] * __expf(-bv[2 * j]), kv[2 * j + 1] * __expf(-bv[2 * j + 1]));
            }
            *(u32x4*)(qe_h + c * 72 + ds) = qo; *(u32x4*)(ke_h + c * 72 + ds) = ko;
            *(u32x4*)(p.gqe + (size_t)ci * 4096 + c * 64 + ds) = qo;
#pragma unroll
            for (int j = 0; j < 8; ++j) kdT_h[(ds + j) * 72 + (c ^ sw)] = (bf16_t)(cvt_pk_bf16(kv[j] * __expf(bl8[j] - bv[j]), 0.f) & 0xffffu);
            const int dv0 = (tid & 7) * 16;
            const u32x4 v0 = va4[h];
            const u32x4 v1 = vb4[h];
#pragma unroll
            for (int j = 0; j < 4; ++j) {
                vT_h[(dv0 + 2 * j) * 72 + (c ^ sw)] = (bf16_t)(v0[j] & 0xffffu); vT_h[(dv0 + 2 * j + 1) * 72 + (c ^ sw)] = (bf16_t)(v0[j] >> 16);
                vT_h[(dv0 + 8 + 2 * j) * 72 + (c ^ sw)] = (bf16_t)(v1[j] & 0xffffu); vT_h[(dv0 + 8 + 2 * j + 1) * 72 + (c ^ sw)] = (bf16_t)(v1[j] >> 16);
            }
            if (tid < 64) p.gdec[(size_t)ci * 64 + tid] = __expf(bcum[63 * 256 + h * 64 + tid] + bcum[31 * 256 + h * 64 + tid]);
        }
        __syncthreads();
#pragma unroll
        for (int i = 0; i < 2; ++i) {
            const int id = w * 2 + i, ct = id >> 2, st = id & 3;
            f32x4 a = {0.f, 0.f, 0.f, 0.f};
            if (st <= ct) {
#pragma unroll
                for (int ks = 0; ks < 2; ++ks) {
                    const bf16x8 ak = *(const bf16x8*)(ke_h + (st * 16 + fr) * 72 + ks * 32 + q4 * 8);
                    const bf16x8 bq = *(const bf16x8*)(qe_h + (ct * 16 + fr) * 72 + ks * 32 + q4 * 8);
                    a = mfma16(ak, bq, a);
                }
            }
            const int c = ct * 16 + fr;
#pragma unroll
            for (int r = 0; r < 4; ++r) { const int s2 = st * 16 + q4 * 4 + r; if (s2 > c) a[r] = 0.f; }
            u32x2 o; o.x = cvt_pk_bf16(a[0], a[1]); o.y = cvt_pk_bf16(a[2], a[3]);
            *(u32x2*)(p.gatt + (size_t)ci * 4096 + c * 64 + st * 16 + q4 * 4) = o;
        }
        {
            const int r = tid >> 3, cs = (tid & 7) * 8;
            *(u32x4*)(p.gkdT + (size_t)ci * 4096 + r * 64 + cs) = *(const u32x4*)(kdT_h + r * 72 + (cs ^ (((r >> 3) & 7) * 8)));
            *(u32x4*)(p.gvT + (size_t)ci * 8192 + r * 64 + cs) = *(const u32x4*)(vT_h + r * 72 + (cs ^ (((r >> 4) & 7) * 8)));
            *(u32x4*)(p.gvT + (size_t)ci * 8192 + (64 + r) * 64 + cs) = *(const u32x4*)(vT_h + (64 + r) * 72 + (cs ^ ((((64 + r) >> 4) & 7) * 8)));
        }
    }
    __syncthreads();
}

DI void diff_prep(const Params& p, int l, int tile, unsigned char* lds) {
    const int tid = get_tid();
    const int t0 = tile * 64, b = t0 >> 11, s0 = t0 & 2047;
    bf16_t* vs = (bf16_t*)lds;
    {
        const int g = tid >> 4, i16 = tid & 15;
        const int d0 = i16 * 8, fi = (i16 & 7) * 8;
        float qw[8], kw[8];
#pragma unroll
        for (int j = 0; j < 8; ++j) { qw[j] = p.diff_q_norm_w[l * 128 + d0 + j]; kw[j] = p.diff_k_norm_w[l * 128 + d0 + j]; }
#pragma unroll 1
        for (int pass = 0; pass < 2; ++pass) {
            const int tk = pass * 32 + g, t = t0 + tk;
            const f32x4 cs0 = *(const f32x4*)(p.rope + (size_t)t * 128 + fi), cs1 = *(const f32x4*)(p.rope + (size_t)t * 128 + fi + 4);
            const f32x4 sn0 = *(const f32x4*)(p.rope + (size_t)t * 128 + 64 + fi), sn1 = *(const f32x4*)(p.rope + (size_t)t * 128 + 64 + fi + 4);
            u32x4 vreg[8];
#pragma unroll
            for (int i = 0; i < 8; ++i) { const int e = tid + (pass * 8 + i) * 512; vreg[i] = __builtin_nontemporal_load((const u32x4*)(p.proj + (size_t)(t0 + (e >> 7)) * NPROJ + 5632 + (e & 127) * 8)); }
            u32x4 raw16[16];
#pragma unroll
            for (int vec = 0; vec < 16; ++vec) raw16[vec] = __builtin_nontemporal_load((const u32x4*)(p.proj + (size_t)t * NPROJ + 3584 + vec * 128 + d0));
#pragma unroll
            for (int i = 0; i < 8; ++i) { const int e = tid + (pass * 8 + i) * 512; *(u32x4*)(vs + (e >> 7) * 1032 + (e & 127) * 8) = vreg[i]; }
#pragma unroll
            for (int vec = 0; vec < 16; ++vec) {
                const int isk = vec >> 3, hm = vec & 7;
                float v[8];
#pragma unroll
                for (int j = 0; j < 4; ++j) { v[2 * j] = bf_lo(raw16[vec][j]); v[2 * j + 1] = bf_hi(raw16[vec][j]); }
                float ss = 0.f;
#pragma unroll
                for (int j = 0; j < 8; ++j) ss += v[j] * v[j];
                ss = sum16(ss);
                const float rstd = rsqrtf(ss * (1.f / 128.f) + 1e-6f);
                const float sc = isk ? 1.f : 0.08838834764831845f * 1.4426950408889634f;
                float o[8];
#pragma unroll
                for (int j = 0; j < 8; ++j) {
                    const float y = v[j] * rstd * (isk ? kw[j] : qw[j]);
                    const float oth = dpp_f<0x128>(y);
                    const float cs = (j < 4 ? cs0 : cs1)[j & 3], sn = (j < 4 ? sn0 : sn1)[j & 3];
                    o[j] = ((i16 < 8) ? (y * cs - oth * sn) : (y * cs + oth * sn)) * sc;
                }
                u32x4 ov; ov.x = cvt_pk_bf16(o[0], o[1]); ov.y = cvt_pk_bf16(o[2], o[3]); ov.z = cvt_pk_bf16(o[4], o[5]); ov.w = cvt_pk_bf16(o[6], o[7]);
                bf16_t* dst = (isk ? p.kd : p.qd) + ((size_t)((b * 8 + hm) * SEQ + s0 + tk)) * 128 + d0;
                *(u32x4*)dst = ov;
            }
        }
    }
    __syncthreads();
    {
        const int c2 = tid * 2, hh = c2 >> 8, dv = c2 & 255;
        bf16_t* dst = p.vT + ((size_t)((b * 4 + hh) * 32 + (s0 >> 6)) * 256 + dv) * 64;
#pragma unroll
        for (int seg = 0; seg < 8; ++seg) {
            unsigned wv[8];
#pragma unroll
            for (int j = 0; j < 8; ++j) wv[j] = *(const unsigned*)(vs + (seg * 8 + j) * 1032 + c2);
            u32x4 r0, r1;
#pragma unroll
            for (int j = 0; j < 4; ++j) { r0[j] = (wv[2 * j] & 0xffffu) | (wv[2 * j + 1] << 16); r1[j] = (wv[2 * j] >> 16) | (wv[2 * j + 1] & 0xffff0000u); }
            *(u32x4*)(dst + seg * 8) = r0; *(u32x4*)(dst + 64 + seg * 8) = r1;
        }
    }
    __syncthreads();
}

DI void phase3(const Params& p, int l, unsigned char* lds, int mask, int stop) {
    for (int it = get_bid(); it < 768; it += gridDim.x) {
        if (it < 512) { if (mask & 1) gdn_prep(p, l, it, lds, stop); }
        else if (it < 640) { if (mask & 2) gla_prep(p, l, it - 512, lds); }
        else if (mask & 4) diff_prep(p, l, it - 640, lds);
    }
}

DI void lds_barrier() { asm volatile("s_waitcnt lgkmcnt(0)" ::: "memory"); __builtin_amdgcn_s_barrier(); asm volatile("" ::: "memory"); }

struct GlaOps { bf16x8 att[2], vt[2][2], qe[2], kd[2]; f32x4 dec; };
DI void gla_load(const Params& p, size_t ci, int t2, int dh, int sl, int fr, int q4, GlaOps& o) {
    const bf16_t* att = p.gatt + ci * 4096 + (t2 * 16 + fr) * 64 + q4 * 8;
    const bf16_t* qe = p.gqe + ci * 4096 + (t2 * 16 + fr) * 64 + q4 * 8;
    const bf16_t* kdT = p.gkdT + ci * 4096 + (t2 * 16 + fr) * 64 + q4 * 8;
#pragma unroll
    for (int ks = 0; ks < 2; ++ks) { o.att[ks] = *(const bf16x8*)(att + ks * 32); o.qe[ks] = *(const bf16x8*)(qe + ks * 32); o.kd[ks] = *(const bf16x8*)(kdT + ks * 32); }
#pragma unroll
    for (int e = 0; e < 2; ++e) {
        const bf16_t* vT = p.gvT + ci * 8192 + (size_t)(sl * 64 + (2 * dh + e) * 16 + fr) * 64 + q4 * 8;
#pragma unroll
        for (int ks = 0; ks < 2; ++ks) o.vt[e][ks] = *(const bf16x8*)(vT + ks * 32);
    }
    o.dec = *(const f32x4*)(p.gdec + ci * 64 + t2 * 16 + q4 * 4);
}
DI void gla_chain(const Params& p, int id, unsigned char* lds) {
    const int tid = get_tid(), w = tid >> 6, lane = tid & 63, fr = lane & 15, q4 = lane >> 4;
    const int sl = id & 1, bh = id >> 1;
    bf16_t* St = (bf16_t*)lds;
    const int t2 = w >> 1, dh = w & 1;
    const int b = bh >> 2, h = bh & 3;
    f32x4 Sacc[2] = {{0.f, 0.f, 0.f, 0.f}, {0.f, 0.f, 0.f, 0.f}};
    auto step = [&](int n, const GlaOps& cur) {
#pragma unroll
        for (int e = 0; e < 2; ++e) { u32x2 o; o.x = cvt_pk_bf16(Sacc[e][0], Sacc[e][1]); o.y = cvt_pk_bf16(Sacc[e][2], Sacc[e][3]);
          *(u32x2*)(St + ((2 * dh + e) * 16 + fr) * 72 + t2 * 16 + q4 * 4) = o; }
        lds_barrier();
#pragma unroll
        for (int e = 0; e < 2; ++e) {
            f32x4 o = {0.f, 0.f, 0.f, 0.f};
#pragma unroll
            for (int ks = 0; ks < 2; ++ks) o = mfma16(cur.att[ks], cur.vt[e][ks], o);
#pragma unroll
            for (int ks = 0; ks < 2; ++ks) {
                const bf16x8 bs = *(const bf16x8*)(St + ((2 * dh + e) * 16 + fr) * 72 + ks * 32 + q4 * 8);
                o = mfma16(cur.qe[ks], bs, o);
            }
            float* dst = p.ogla + (size_t)(b * SEQ + n * 64 + t2 * 16 + q4 * 4) * 512 + h * 128 + sl * 64 + (2 * dh + e) * 16 + fr;
#pragma unroll
            for (int r = 0; r < 4; ++r) dst[r * 512] = o[r];
            Sacc[e] = Sacc[e] * cur.dec;
#pragma unroll
            for (int ks = 0; ks < 2; ++ks) Sacc[e] = mfma16(cur.kd[ks], cur.vt[e][ks], Sacc[e]);
        }
        lds_barrier();
    };
    GlaOps r0, r1, r2;
    const size_t c0 = (size_t)bh * 32;
    gla_load(p, c0 + 0, t2, dh, sl, fr, q4, r0); gla_load(p, c0 + 1, t2, dh, sl, fr, q4, r1); gla_load(p, c0 + 2, t2, dh, sl, fr, q4, r2);
#pragma unroll 1
    for (int n = 0; n < 33; n += 3) {
        step(n, r0);     gla_load(p, c0 + min(n + 3, 31), t2, dh, sl, fr, q4, r0);
        step(n + 1, r1); gla_load(p, c0 + min(n + 4, 31), t2, dh, sl, fr, q4, r1);
        if (n + 2 < 32) { step(n + 2, r2); gla_load(p, c0 + min(n + 5, 31), t2, dh, sl, fr, q4, r2); }
    }
}

struct GdnOps { bf16x8 am[4], qk[2], kt[2]; float u[4][4]; float cd; };
DI void gdn_load(const Params& p, size_t ci, int w, int ct, int role, int sl, int fr, int q4, GdnOps& o) {
    const bf16_t* am = (role ? p.dqe : p.dw) + ci * 8192 + (ct * 16 + fr) * 128 + q4 * 8;
    const bf16_t* ktT = p.dktT + ci * 8192 + (w * 16 + fr) * 64 + q4 * 8;
#pragma unroll
    for (int ks = 0; ks < 4; ++ks) o.am[ks] = *(const bf16x8*)(am + ks * 32);
#pragma unroll
    for (int ks = 0; ks < 2; ++ks) o.kt[ks] = *(const bf16x8*)(ktT + ks * 32);
    if (role) {
        const bf16_t* qk = p.dqk + ci * 4096 + (ct * 16 + fr) * 64 + q4 * 8;
#pragma unroll
        for (int ks = 0; ks < 2; ++ks) o.qk[ks] = *(const bf16x8*)(qk + ks * 32);
    } else {
#pragma unroll
        for (int e = 0; e < 4; ++e) {
            const float* up = p.du + ci * 8192 + (size_t)(ct * 16 + q4 * 4) * 128 + sl * 64 + e * 16 + fr;
#pragma unroll
            for (int r = 0; r < 4; ++r) o.u[e][r] = up[r * 128];
        }
    }
    o.cd = p.dcd[ci];
}
DI void gdn_chain(const Params& p, int id, unsigned char* lds) {
    const int tid = get_tid(), w = __builtin_amdgcn_readfirstlane(tid >> 6), lane = tid & 63, fr = lane & 15, q4 = lane >> 4;
    const int sl = id & 1, bh = id >> 1;
    bf16_t* St = (bf16_t*)lds;
    bf16_t* VnT = St + 64 * 136;
    const int ct = w >> 1, role = w & 1;
    f32x4 S[4];
#pragma unroll
    for (int i = 0; i < 4; ++i) S[i] = (f32x4){0.f, 0.f, 0.f, 0.f};
    const int b = bh >> 2, h = bh & 3;
    auto step = [&](int n, const GdnOps& cur) {
#pragma unroll
        for (int d = 0; d < 4; ++d) { u32x2 o; o.x = cvt_pk_bf16(S[d][0], S[d][1]); o.y = cvt_pk_bf16(S[d][2], S[d][3]);
          *(u32x2*)(St + (d * 16 + fr) * 136 + w * 16 + q4 * 4) = o; }
        lds_barrier();
        f32x4 acc[4];
#pragma unroll
        for (int e = 0; e < 4; ++e) {
            acc[e] = (f32x4){0.f, 0.f, 0.f, 0.f};
#pragma unroll
            for (int ks = 0; ks < 4; ++ks) {
                const bf16x8 bs = *(const bf16x8*)(St + (e * 16 + fr) * 136 + ks * 32 + q4 * 8);
                acc[e] = mfma16(cur.am[ks], bs, acc[e]);
            }
        }
        if (role == 0) {
#pragma unroll
            for (int e = 0; e < 4; ++e) {
                u32x2 pk; pk.x = cvt_pk_bf16(cur.u[e][0] - acc[e][0], cur.u[e][1] - acc[e][1]); pk.y = cvt_pk_bf16(cur.u[e][2] - acc[e][2], cur.u[e][3] - acc[e][3]);
                *(u32x2*)(VnT + (e * 16 + fr) * 72 + ct * 16 + q4 * 4) = pk;
            }
        }
        lds_barrier();
        if (role == 1) {
#pragma unroll
            for (int e = 0; e < 4; ++e) {
#pragma unroll
                for (int ks = 0; ks < 2; ++ks) { const bf16x8 bo = *(const bf16x8*)(VnT + (e * 16 + fr) * 72 + ks * 32 + q4 * 8); acc[e] = mfma16(cur.qk[ks], bo, acc[e]); }
                float* dst = p.ogdn + (size_t)(b * SEQ + n * 64 + ct * 16 + q4 * 4) * 512 + h * 128 + sl * 64 + e * 16 + fr;
#pragma unroll
                for (int r = 0; r < 4; ++r) dst[r * 512] = acc[e][r];
            }
        }
#pragma unroll
        for (int d = 0; d < 4; ++d) {
            S[d] = S[d] * cur.cd;
#pragma unroll
            for (int ks = 0; ks < 2; ++ks) { const bf16x8 bv = *(const bf16x8*)(VnT + (d * 16 + fr) * 72 + ks * 32 + q4 * 8); S[d] = mfma16(cur.kt[ks], bv, S[d]); }
        }
    };
    GdnOps r0, r1;
    const size_t c0 = (size_t)bh * 32;
    gdn_load(p, c0 + 0, w, ct, role, sl, fr, q4, r0); gdn_load(p, c0 + 1, w, ct, role, sl, fr, q4, r1);
#pragma unroll 1
    for (int n = 0; n < 32; n += 2) {
        step(n, r0);     gdn_load(p, c0 + min(n + 2, 31), w, ct, role, sl, fr, q4, r0);
        step(n + 1, r1); gdn_load(p, c0 + min(n + 3, 31), w, ct, role, sl, fr, q4, r1);
    }
    __syncthreads();
}

DI void attn_item(const Params& p, int l, int item, unsigned char* lds, int ktmul) {
    const int tid = get_tid(), w = __builtin_amdgcn_readfirstlane(tid >> 6), lane = tid & 63, fr = lane & 15, q4 = lane >> 4;
    const int qb = 31 - (item >> 4), bh = item & 15, b = bh >> 2, h = bh & 3;
    const int m = w >> 2, rt = w & 3;
    const int q0 = qb * 64;
    const float lam = p.lam[l];
    LAS unsigned char* L = (LAS unsigned char*)lds;
    const bf16_t* qg = p.qd + ((size_t)((b * 8 + h * 2 + m) * SEQ + q0 + rt * 16 + fr)) * 128;
    bf16x8 qf[4];
#pragma unroll
    for (int ks = 0; ks < 4; ++ks) qf[ks] = *(const bf16x8*)(qg + ks * 32 + q4 * 8);
    const bf16_t* kg = p.kd + ((size_t)(b * 8 + h * 2) * SEQ) * 128;
    const bf16_t* vg = p.vT + ((size_t)(b * 4 + h) * 32) * 16384;
    unsigned koff[4], voff[4];
#pragma unroll
    for (int i = 0; i < 4; ++i) {
        const int gk = w * 4 + i;
        const int rk = gk * 4 + (lane >> 4), ck = (lane & 15) ^ ((rk & 3) | (((rk >> 3) & 3) << 2));
        koff[i] = (unsigned)(((rk >> 6) * SEQ + (rk & 63)) * 128 + ck * 8);
        const int gv = w * 4 + i;
        const int rv = gv * 8 + (lane >> 3), cv = (lane & 7) ^ ((rv >> 1) & 7);
        voff[i] = (unsigned)(rv * 64 + cv * 8);
    }
    auto issue_tile = [&](int kt, int buf) {
#pragma unroll
        for (int i = 0; i < 4; ++i) {
            __builtin_amdgcn_global_load_lds((const unsigned*)(kg + (size_t)kt * 64 * 128 + koff[i]), (LAS unsigned*)(L + buf * 65536 + (w * 4 + i) * 1024), 16, 0, 0);
            __builtin_amdgcn_global_load_lds((const unsigned*)(vg + (size_t)kt * 16384 + voff[i]), (LAS unsigned*)(L + buf * 65536 + 32768 + (w * 4 + i) * 1024), 16, 0, 0);
        }
    };
    f32x4 O[16];
#pragma unroll
    for (int i = 0; i < 16; ++i) O[i] = (f32x4){0.f, 0.f, 0.f, 0.f};
    float mrun = 0.f, lrun = 0.f;
    const int qglob = q0 + rt * 16 + fr;
    const int krow = (fr >> 2) * 8 + (fr & 3);
    const unsigned kro = (unsigned)((m * 64 + krow) * 256);
    const unsigned vro = (unsigned)(fr * 128);
    const int vsw = (fr >> 1) & 7;
    issue_tile(0, 0);
    for (int kt = 0; kt <= qb; ++kt) {
        asm volatile("s_waitcnt vmcnt(0)" ::: "memory");
        __syncthreads();
        const int buf = kt & 1;
        if (kt < qb) issue_tile((kt + 1) * ktmul, buf ^ 1);
        const LAS unsigned char* Kb = L + buf * 65536 + kro;
        const LAS unsigned char* Vb = L + buf * 65536 + 32768 + vro;
        f32x4 sc[4];
        const float negm = -mrun;
#pragma unroll
        for (int j = 0; j < 4; ++j) {
            sc[j] = (f32x4){negm, negm, negm, negm};
#pragma unroll
            for (int ks = 0; ks < 4; ++ks) {
                const bf16x8 a = *(const LAS bf16x8*)(Kb + ((j >> 1) * 32 + (j & 1) * 4) * 256 + (((ks * 4 + q4) ^ fr) << 4));
                sc[j] = mfma16(a, qf[ks], sc[j]);
            }
        }
        if (kt == qb) {
#pragma unroll
            for (int j = 0; j < 4; ++j)
#pragma unroll
                for (int r = 0; r < 4; ++r) if (kt * 64 + (j >> 1) * 32 + q4 * 8 + (j & 1) * 4 + r > qglob) sc[j][r] = -1e30f;
        }
        float tm = -1e30f;
#pragma unroll
        for (int j = 0; j < 4; ++j)
#pragma unroll
            for (int r = 0; r < 4; ++r) tm = fmaxf(tm, sc[j][r]);
        tm = xch16_max(tm); tm = xch32_max(tm);
        if (__builtin_amdgcn_ballot_w64(tm > 6.0f) != 0ull) {
            const float d = fmaxf(tm, 0.f);
            const float alpha = __builtin_amdgcn_exp2f(-d);
            mrun += d;
            lrun *= alpha;
#pragma unroll
            for (int i = 0; i < 16; ++i) O[i] = O[i] * alpha;
#pragma unroll
            for (int j = 0; j < 4; ++j)
#pragma unroll
                for (int r = 0; r < 4; ++r) sc[j][r] -= d;
        }
        float ps = 0.f;
#pragma unroll
        for (int j = 0; j < 4; ++j)
#pragma unroll
            for (int r = 0; r < 4; ++r) { const float pv = __builtin_amdgcn_exp2f(sc[j][r]); sc[j][r] = pv; ps += pv; }
        lrun += ps;
        bf16x8 pf[2];
#pragma unroll
        for (int k2 = 0; k2 < 2; ++k2) {
            u32x4 t; t.x = cvt_pk_bf16(sc[2 * k2][0], sc[2 * k2][1]); t.y = cvt_pk_bf16(sc[2 * k2][2], sc[2 * k2][3]);
            t.z = cvt_pk_bf16(sc[2 * k2 + 1][0], sc[2 * k2 + 1][1]); t.w = cvt_pk_bf16(sc[2 * k2 + 1][2], sc[2 * k2 + 1][3]);
            pf[k2] = as_bf16x8(t);
        }
#pragma unroll
        for (int dvt = 0; dvt < 16; ++dvt)
#pragma unroll
            for (int k2 = 0; k2 < 2; ++k2) {
                const bf16x8 av = *(const LAS bf16x8*)(Vb + dvt * 2048 + (((4 * k2 + q4) ^ vsw) << 4));
                O[dvt] = mfma16(av, pf[k2], O[dvt]);
            }
    }
    lrun = xch16_add(lrun); lrun = xch32_add(lrun);
    const float fac = (m == 0 ? 1.f : lam) / lrun;
    __syncthreads();
    float* Ox = (float*)lds;
    if (m == 1) {
#pragma unroll
        for (int dvt = 0; dvt < 16; ++dvt) *(f32x4*)(Ox + (rt * 16 + fr) * 260 + dvt * 16 + q4 * 4) = O[dvt] * fac;
    }
    __syncthreads();
    if (m == 0) {
        float ss = 0.f;
#pragma unroll
        for (int dvt = 0; dvt < 16; ++dvt) {
            const f32x4 o2 = *(const f32x4*)(Ox + (rt * 16 + fr) * 260 + dvt * 16 + q4 * 4);
            O[dvt] = O[dvt] * fac - o2;
            ss += O[dvt][0] * O[dvt][0] + O[dvt][1] * O[dvt][1] + O[dvt][2] * O[dvt][2] + O[dvt][3] * O[dvt][3];
        }
        ss = xch16_add(ss); ss = xch32_add(ss);
        const float lam_init = 0.8f - 0.6f * expf(-0.3f * (float)l);
        const float rstd = rsqrtf(ss * (1.f / 256.f) + 1e-6f) * (1.f - lam_init);
        const size_t t = (size_t)b * SEQ + qglob;
        u32x2 zr16[16]; f32x4 nw16[16];
#pragma unroll
        for (int dvt = 0; dvt < 16; ++dvt) {
            zr16[dvt] = *(const u32x2*)(p.proj + t * NPROJ + 6656 + h * 256 + dvt * 16 + q4 * 4);
            nw16[dvt] = *(const f32x4*)(p.diff_norm_w + l * 256 + dvt * 16 + q4 * 4);
        }
#pragma unroll
        for (int dvt = 0; dvt < 16; ++dvt) {
            const int dv = dvt * 16 + q4 * 4;
            const f32x4 nw = nw16[dvt];
            const u32x2 zr = zr16[dvt];
            const float z0 = bf_lo(zr.x), z1 = bf_hi(zr.x), z2 = bf_lo(zr.y), z3 = bf_hi(zr.y);
            u32x2 ov;
            ov.x = cvt_pk_bf16(O[dvt][0] * rstd * nw[0] * siluf(z0), O[dvt][1] * rstd * nw[1] * siluf(z1));
            ov.y = cvt_pk_bf16(O[dvt][2] * rstd * nw[2] * siluf(z2), O[dvt][3] * rstd * nw[3] * siluf(z3));
            *(u32x2*)(p.concat + t * DM + 1024 + h * 256 + dv) = ov;
        }
    }
    __syncthreads();
}

DI void phase4(const Params& p, int lc, unsigned char* lds) {
    const int l = lc & 1;
    const int bid = get_bid();
    if (!((PROBE_PHASE == 42 || PROBE_PHASE == 43) && lc >= 2)) {
    if (bid < 32) gdn_chain(p, bid, lds);
    else if (bid < 64) gla_chain(p, bid - 32, lds);
    }
    if (PROBE_PHASE == 41 && lc >= 2) return;
    unsigned* slot = (unsigned*)(lds + LDS_BYTES - 16);
    const int xcd = bid & 7;
    for (;;) {
        __syncthreads();
        if (get_tid() == 0) *slot = atomicAdd(p.cnt + lc * 8 + xcd, 1u);
        __syncthreads();
        const unsigned idx = *slot;
        if (idx >= 64u) break;
        attn_item(p, l, (int)(((idx >> 1) << 4) | (2 * xcd + (idx & 1))), lds, (PROBE_PHASE == 43 && lc >= 2) ? 0 : 1);
    }
}

DI void phase5(const Params& p, int l) {
    const int tid = get_tid();
    const int i16 = tid & 15;
    const int gidx = get_bid() * 32 + (tid >> 4), gstride = gridDim.x * 32;
    const f32x4 nwa0 = *(const f32x4*)(p.gla_norm_w + l * 128 + i16 * 8), nwa1 = *(const f32x4*)(p.gla_norm_w + l * 128 + i16 * 8 + 4);
    const f32x4 nwd0 = *(const f32x4*)(p.gdn_norm_w + l * 128 + i16 * 8), nwd1 = *(const f32x4*)(p.gdn_norm_w + l * 128 + i16 * 8 + 4);
    for (int it0 = gidx; it0 < TT * 8; it0 += 4 * gstride) {
        f32x4 v0[4], v1[4]; u32x4 zr[4];
#pragma unroll
        for (int u = 0; u < 4; ++u) {
            int it = it0 + u * gstride; if (it >= TT * 8) it = it0; const int t = it >> 3, g = (it >> 2) & 1, h = it & 3;
            const float* src = (g ? p.ogdn : p.ogla) + (size_t)t * 512 + h * 128 + i16 * 8;
            v0[u] = *(const f32x4*)src; v1[u] = *(const f32x4*)(src + 4);
            zr[u] = *(const u32x4*)(p.proj + (size_t)t * NPROJ + (g ? 3072 : 1024) + h * 128 + i16 * 8);
        }
#pragma unroll
        for (int u = 0; u < 4; ++u) {
            const int it = it0 + u * gstride; if (it >= TT * 8) break; const int t = it >> 3, g = (it >> 2) & 1, h = it & 3;
            float ss = v0[u][0] * v0[u][0] + v0[u][1] * v0[u][1] + v0[u][2] * v0[u][2] + v0[u][3] * v0[u][3]
                     + v1[u][0] * v1[u][0] + v1[u][1] * v1[u][1] + v1[u][2] * v1[u][2] + v1[u][3] * v1[u][3];
            ss = sum16(ss);
            const float rstd = rsqrtf(ss * (1.f / 128.f) + 1e-6f);
            const f32x4 n0 = g ? nwd0 : nwa0, n1 = g ? nwd1 : nwa1;
            u32x4 o;
            o.x = cvt_pk_bf16(v0[u][0] * rstd * n0[0] * siluf(bf_lo(zr[u].x)), v0[u][1] * rstd * n0[1] * siluf(bf_hi(zr[u].x)));
            o.y = cvt_pk_bf16(v0[u][2] * rstd * n0[2] * siluf(bf_lo(zr[u].y)), v0[u][3] * rstd * n0[3] * siluf(bf_hi(zr[u].y)));
            o.z = cvt_pk_bf16(v1[u][0] * rstd * n1[0] * siluf(bf_lo(zr[u].z)), v1[u][1] * rstd * n1[1] * siluf(bf_hi(zr[u].z)));
            o.w = cvt_pk_bf16(v1[u][2] * rstd * n1[2] * siluf(bf_lo(zr[u].w)), v1[u][3] * rstd * n1[3] * siluf(bf_hi(zr[u].w)));
            *(u32x4*)(p.concat + (size_t)t * DM + g * 512 + h * 128 + i16 * 8) = o;
        }
    }
}

#define XB_TMO      128
#define XB_XCNT(j)  (256  + 64 * (j))
#define XB_XSUB(j)  (1280 + 64 * (j))
#define XB_XGEN(j)  (2304 + 64 * (j))
#define XB_TOP      3328
#define XB_TOPGEN   3392
#define XCD_BAR_WORDS 3456
#define XB_SPIN_CAP (1u << 18)
DI unsigned xb_ld(unsigned* q)              { return __hip_atomic_load(q, __ATOMIC_RELAXED, __HIP_MEMORY_SCOPE_AGENT); }
DI unsigned xb_add(unsigned* q, unsigned v) { return __hip_atomic_fetch_add(q, v, __ATOMIC_RELAXED, __HIP_MEMORY_SCOPE_AGENT); }
DI unsigned xb_xcc_id() { return (unsigned)__builtin_amdgcn_s_getreg((3 << 11) | 20) & 0xFu; }
#define XB_SPIN(cond, bar) do { unsigned _sp = 0; while (cond) { __builtin_amdgcn_s_sleep(1); \
    if ((++_sp & 255u) == 0u) { if (xb_ld(&(bar)[XB_TMO])) break; if (_sp > XB_SPIN_CAP) { atomicAdd(&(bar)[XB_TMO], 1u); break; } } } } while (0)
struct XcdBarrier { unsigned* bar; unsigned x; volatile LAS unsigned* st; };
DI XcdBarrier xcd_barrier_post(unsigned* bar, volatile LAS unsigned* st) {
    XcdBarrier b; b.bar = bar; b.x = xb_xcc_id(); b.st = st;
    if (threadIdx.x == 0) (void)xb_add(&bar[XB_XCNT(b.x)], 1u);
    return b;
}
DI void xcd_barrier_complete(unsigned* bar, unsigned x, unsigned& nloc, unsigned& nx) {
    const unsigned G = gridDim.x * gridDim.y * gridDim.z;
    unsigned sum, cnt, mine, sp = 0u;
    for (;;) {
        sum = 0u; cnt = 0u; mine = 0u;
#pragma unroll
        for (unsigned j = 0; j < 16; ++j) { const unsigned c = xb_ld(&bar[XB_XCNT(j)]); sum += c; cnt += (c > 0u) ? 1u : 0u; mine = (j == x) ? c : mine; }
        if (sum == G) break;
        __builtin_amdgcn_s_sleep(1);
        if ((++sp & 255u) == 0u) { if (xb_ld(&bar[XB_TMO])) break; if (sp > XB_SPIN_CAP) { atomicAdd(&bar[XB_TMO], 1u); break; } }
    }
    nloc = mine > 0u ? mine : 1u; nx = cnt > 0u ? cnt : 1u;
}
DI void xcd_barrier(const XcdBarrier& b) {
    asm volatile("s_waitcnt vmcnt(0)" ::: "memory");
    __syncthreads();
    if (threadIdx.x == 0) {
        unsigned* bar = b.bar;
        __builtin_amdgcn_s_waitcnt(0);
        unsigned nloc = b.st[0], nx = b.st[1];
        if (nloc == 0u) { xcd_barrier_complete(bar, b.x, nloc, nx); b.st[0] = nloc; b.st[1] = nx; }
        const unsigned old = xb_add(&bar[XB_XSUB(b.x)], 1u);
        const unsigned gen = old / nloc;
        if (old + 1u == (gen + 1u) * nloc) {
            __builtin_amdgcn_fence(__ATOMIC_RELEASE, "agent");
            asm volatile("s_waitcnt vmcnt(0)" ::: "memory");
            const unsigned og = xb_add(&bar[XB_TOP], 1u);
            const unsigned tg = og / nx;
            if (og + 1u == (tg + 1u) * nx) xb_add(&bar[XB_TOPGEN], 1u);
            else XB_SPIN(xb_ld(&bar[XB_TOPGEN]) == tg, bar);
            __builtin_amdgcn_fence(__ATOMIC_ACQUIRE, "agent");
            xb_add(&bar[XB_XGEN(b.x)], 1u);
            asm volatile("s_waitcnt vmcnt(0)" ::: "memory");
        } else {
            XB_SPIN(xb_ld(&bar[XB_XGEN(b.x)]) == gen, bar);
            __builtin_amdgcn_fence(__ATOMIC_ACQUIRE, "agent");
            asm volatile("s_waitcnt vmcnt(0)" ::: "memory");
        }
    }
    __syncthreads();
}

__global__ void __launch_bounds__(512, 2) fwd_megakernel(Params p_unused) {
    extern __shared__ __attribute__((aligned(16))) unsigned char shm[];
    cg::grid_group grid = cg::this_grid();
    volatile LAS unsigned* xst = (volatile LAS unsigned*)((LAS unsigned char*)shm + (LDS_BYTES - 32));
    if (threadIdx.x < 2) xst[threadIdx.x] = 0u;
    __syncthreads();
    XcdBarrier xb;
    { const Params p = load_params(); xb = xcd_barrier_post(p.bar, xst); }
    { const Params p = load_params(); phase0(p, (float*)shm); }
    grid.sync();
#if PROBE_PHASE == 10
    { const Params p = load_params(); phase0(p, (float*)shm); }
    xcd_barrier(xb);
#endif
#pragma unroll 1
    for (int l = 0; l < 2; ++l) {
#pragma unroll 1
        for (int rep = 0; rep < (PROBE_PHASE == 1 ? 2 : 1); ++rep) {
        { const Params p = load_params(); phase1(p, l, l == 0 ? p.x : p.x1); }
        xcd_barrier(xb);
        }
#pragma unroll 1
        for (int rep = 0; rep < (PROBE_PHASE == 2 ? 2 : 1); ++rep) {
            const Params p = load_params();
            pg8::StaticOrder S; S.init(TT, NPAD, (int)gridDim.x, get_bid());
            pg8::Gemm g{p.hbuf, p.WinT + (size_t)l * NPAD * 2048, TT, NPAD, 2048};
            EpiProj E{p.proj, p.small};
            pg8::gemm_phase<EpiProj>((LAS unsigned char*)shm, g, S, E);
            xcd_barrier(xb);
        }
#pragma unroll 1
        for (int rep = 0; rep < ((PROBE_PHASE == 3 || (PROBE_PHASE >= 31 && PROBE_PHASE <= 36)) ? 2 : 1); ++rep) {
        { const Params p = load_params(); phase3(p, l, shm, (rep == 0 || PROBE_PHASE == 3) ? 7 : (PROBE_PHASE == 32 ? 2 : (PROBE_PHASE == 33 ? 4 : 1)), (rep == 1 && PROBE_PHASE >= 34) ? PROBE_PHASE - 33 : 0); }
        xcd_barrier(xb);
        }
#pragma unroll 1
        for (int rep = 0; rep < ((PROBE_PHASE == 4 || PROBE_PHASE == 41 || PROBE_PHASE == 42 || PROBE_PHASE == 43) ? 2 : 1); ++rep) {
        { Params p = load_params(); if (PROBE_PHASE == 43 && rep == 1) p.concat = p.hbuf; phase4(p, l + 2 * rep, shm); }
        xcd_barrier(xb);
        }
#pragma unroll 1
        for (int rep = 0; rep < (PROBE_PHASE == 5 ? 2 : 1); ++rep) {
        { const Params p = load_params(); phase5(p, l); }
        xcd_barrier(xb);
        }
#pragma unroll 1
        for (int rep = 0; rep < (PROBE_PHASE == 6 ? 2 : 1); ++rep) {
            const Params p = load_params();
            pg8::StaticOrder S; S.init(TT, DM, (int)gridDim.x, get_bid());
            pg8::Gemm g{p.concat, p.WoutT + (size_t)l * 2048 * 2048, TT, DM, 2048};
            EpiOut E{l == 0 ? p.x : p.x1, l == 0 ? p.x1 : p.out, p.mod + (size_t)l * 4 * 6144 + 4096};
            pg8::gemm_phase<EpiOut>((LAS unsigned char*)shm, g, S, E);
            xcd_barrier(xb);
        }
    }
}

#ifdef MULTI_LAUNCH
__global__ void __launch_bounds__(512, 2) k_p0(Params p) { extern __shared__ __attribute__((aligned(16))) unsigned char shm[]; phase0(p, (float*)shm); }
__global__ void __launch_bounds__(512, 2) k_p1(Params p, int l) { phase1(p, l, l == 0 ? p.x : p.x1); }
__global__ void __launch_bounds__(512, 2) k_p2(Params p, int l) { extern __shared__ __attribute__((aligned(16))) unsigned char shm[];
    pg8::StaticOrder S; S.init(TT, NPAD, (int)gridDim.x, (int)blockIdx.x);
    pg8::Gemm g{p.hbuf, p.WinT + (size_t)l * NPAD * 2048, TT, NPAD, 2048};
    EpiProj E{p.proj, p.small};
    pg8::gemm_phase<EpiProj>((LAS unsigned char*)shm, g, S, E); }
__global__ void __launch_bounds__(512, 2) k_p3a(Params p, int l) { extern __shared__ __attribute__((aligned(16))) unsigned char shm[]; for (int it = blockIdx.x; it < 512; it += gridDim.x) gdn_prep(p, l, it, shm); }
__global__ void __launch_bounds__(512, 2) k_p3b(Params p, int l) { extern __shared__ __attribute__((aligned(16))) unsigned char shm[]; for (int it = blockIdx.x; it < 128; it += gridDim.x) gla_prep(p, l, it, shm); }
__global__ void __launch_bounds__(512, 2) k_p3c(Params p, int l) { extern __shared__ __attribute__((aligned(16))) unsigned char shm[]; for (int it = blockIdx.x; it < 128; it += gridDim.x) diff_prep(p, l, it, shm); }
__global__ void __launch_bounds__(512, 2) k_p4a(Params p, int l) { extern __shared__ __attribute__((aligned(16))) unsigned char shm[]; gdn_chain(p, blockIdx.x, shm); }
__global__ void __launch_bounds__(512, 2) k_p4b(Params p, int l) { extern __shared__ __attribute__((aligned(16))) unsigned char shm[]; gla_chain(p, blockIdx.x, shm); }
__global__ void __launch_bounds__(512, 2) k_p4c(Params p, int l) { extern __shared__ __attribute__((aligned(16))) unsigned char shm[]; attn_item(p, l, blockIdx.x, shm); }
__global__ void __launch_bounds__(512, 2) k_p5(Params p, int l) { phase5(p, l); }
__global__ void __launch_bounds__(512, 2) k_p6(Params p, int l) { extern __shared__ __attribute__((aligned(16))) unsigned char shm[];
    pg8::StaticOrder S; S.init(TT, DM, (int)gridDim.x, (int)blockIdx.x);
    pg8::Gemm g{p.concat, p.WoutT + (size_t)l * 2048 * 2048, TT, DM, 2048};
    EpiOut E{l == 0 ? p.x : p.x1, l == 0 ? p.x1 : p.out, p.mod + (size_t)l * 4 * 6144 + 4096};
    pg8::gemm_phase<EpiOut>((LAS unsigned char*)shm, g, S, E); }
#endif

extern "C" void kernel_launch(void* const* d_in, const int* in_sizes, int n_in, void* d_out, int out_size, void* d_ws, size_t ws_size, hipStream_t stream) {
    static int grid_blocks = 0;
    if (!grid_blocks) {
        int dev = 0, cus = 0, per_cu = 0;
        hipGetDevice(&dev);
        hipDeviceGetAttribute(&cus, hipDeviceAttributeMultiprocessorCount, dev);
        hipFuncSetAttribute((const void*)fwd_megakernel, hipFuncAttributeMaxDynamicSharedMemorySize, LDS_BYTES);
        hipOccupancyMaxActiveBlocksPerMultiprocessor(&per_cu, fwd_megakernel, 512, LDS_BYTES);
        if (per_cu < 1) per_cu = 1;
        if (per_cu > 1) per_cu = 1;
        grid_blocks = cus * per_cu;
    }
    Params p{};
    p.x = (const float*)d_in[0]; p.c = (const float*)d_in[1]; p.pos = (const int*)d_in[2];
    p.norm_w = (const float*)d_in[3]; p.w_ada = (const float*)d_in[4]; p.b_ada = (const float*)d_in[5]; p.w_in = (const float*)d_in[6];
    p.gla_w_lr = (const float*)d_in[7]; p.gla_b_lr = (const float*)d_in[8]; p.gla_norm_w = (const float*)d_in[9];
    p.gdn_conv_w = (const float*)d_in[10]; p.gdn_a_log = (const float*)d_in[11]; p.gdn_dt_bias = (const float*)d_in[12]; p.gdn_norm_w = (const float*)d_in[13];
    p.diff_q_norm_w = (const float*)d_in[14]; p.diff_k_norm_w = (const float*)d_in[15]; p.diff_lambda = (const float*)d_in[16]; p.diff_norm_w = (const float*)d_in[17];
    p.w_out = (const float*)d_in[18];
    p.out = (float*)d_out;
    char* ws = (char*)d_ws; size_t off = 0;
    auto take = [&](size_t bytes) { char* r = ws + off; off += (bytes + 255) & ~(size_t)255; return r; };
    p.WinT = (bf16_t*)take((size_t)2 * NPAD * 2048 * 2);
    p.WoutT = (bf16_t*)take((size_t)2 * 2048 * 2048 * 2);
    p.mod = (float*)take((size_t)2 * 4 * 6144 * 4);
    p.rope = (float*)take((size_t)TT * 128 * 4);
    p.lam = (float*)take(256);
    p.cnt = (unsigned*)take(256);
    p.bar = (unsigned*)take((size_t)XCD_BAR_WORDS * 4);
    p.hbuf = (bf16_t*)take((size_t)TT * DM * 2);
    p.proj = (bf16_t*)take((size_t)TT * NPROJ * 2);
    p.small = (float*)take((size_t)TT * 32 * 4);
    p.x1 = (float*)d_out;
    p.concat = (bf16_t*)take((size_t)TT * DM * 2);
    p.gqe = (bf16_t*)take((size_t)512 * 4096 * 2);
    p.gatt = (bf16_t*)take((size_t)512 * 4096 * 2);
    p.gkdT = (bf16_t*)take((size_t)512 * 4096 * 2);
    p.gvT = (bf16_t*)take((size_t)512 * 8192 * 2);
    p.gdec = (float*)take((size_t)512 * 64 * 4);
    p.ogla = (float*)p.hbuf;
    p.du = (float*)take((size_t)512 * 8192 * 4);
    p.dw = (bf16_t*)take((size_t)512 * 8192 * 2);
    p.dqe = (bf16_t*)take((size_t)512 * 8192 * 2);
    p.dktT = (bf16_t*)take((size_t)512 * 8192 * 2);
    p.dqk = (bf16_t*)take((size_t)512 * 4096 * 2);
    p.dcd = (float*)take((size_t)512 * 4);
    p.ogdn = (float*)p.hbuf + (size_t)TT * 512;
    p.qd = (bf16_t*)take((size_t)32 * SEQ * 128 * 2);
    p.kd = (bf16_t*)take((size_t)32 * SEQ * 128 * 2);
    p.vT = (bf16_t*)take((size_t)16 * 256 * SEQ * 2);
    if (off > ws_size) { fprintf(stderr, "workspace too small: need %zu have %zu\n", off, ws_size); return; }
    (void)hipMemsetAsync(p.bar, 0, (size_t)XCD_BAR_WORDS * 4, stream);
    void* args[] = {&p};
    hipError_t e = hipLaunchCooperativeKernel((void*)fwd_megakernel, dim3(grid_blocks), dim3(512), args, LDS_BYTES, stream);
    if (e != hipSuccess) fprintf(stderr, "cooperative launch failed: %s (grid %d)\n", hipGetErrorString(e), grid_blocks);
}
```

```cpp
#include <hip/hip_runtime.h>
#include <hip/hip_cooperative_groups.h>
#include <cstdio>
namespace cg = cooperative_groups;

#define DI __device__ __forceinline__
#define LAS __attribute__((address_space(3)))
typedef unsigned short bf16_t;
typedef short bf16x8 __attribute__((ext_vector_type(8)));
typedef float f32x4 __attribute__((ext_vector_type(4)));
typedef float f32x2 __attribute__((ext_vector_type(2)));
typedef unsigned u32x4 __attribute__((ext_vector_type(4)));
typedef unsigned u32x2 __attribute__((ext_vector_type(2)));

constexpr int TT = 8192, DM = 2048, SEQ = 2048, DIN = 7704, NPROJ = 7680, NPAD = 7936;
constexpr int LDS_BYTES = 160 * 1024;
#ifndef PROBE_PHASE
#define PROBE_PHASE 0
#endif

struct Params {
    const float *x, *c; const int* pos;
    const float *norm_w, *w_ada, *b_ada, *w_in, *gla_w_lr, *gla_b_lr, *gla_norm_w, *gdn_conv_w, *gdn_a_log, *gdn_dt_bias,
        *gdn_norm_w, *diff_q_norm_w, *diff_k_norm_w, *diff_lambda, *diff_norm_w, *w_out;
    float* out;
    bf16_t *WinT, *WoutT, *hbuf, *proj, *concat;
    float *mod, *rope, *lam, *small, *x1;
    unsigned* cnt; unsigned* bar;
    bf16_t *gqe, *gatt, *gkdT, *gvT; float *gdec, *ogla;
    float *du; bf16_t *dw, *dqe, *dktT, *dqk; float *dcd, *ogdn;
    bf16_t *qd, *kd, *vT;
};

typedef const __attribute__((address_space(4))) unsigned char* KP4;
DI int get_tid() { int t = threadIdx.x; asm volatile("" : "+v"(t)); return t; }
DI int get_bid() { int b = blockIdx.x; asm volatile("" : "+s"(b)); return b; }
DI Params load_params() { KP4 q = (KP4)__builtin_amdgcn_kernarg_segment_ptr(); asm volatile("" : "+s"(q)); Params r; __builtin_memcpy(&r, q, sizeof(Params)); return r; }
typedef __bf16 bf16x2_t __attribute__((ext_vector_type(2)));
DI unsigned cvt_pk_bf16(float lo, float hi) { const f32x2 v = {lo, hi}; const bf16x2_t r = __builtin_convertvector(v, bf16x2_t); return __builtin_bit_cast(unsigned, r); }
DI float bf_lo(unsigned u) { return __uint_as_float(u << 16); }
DI float bf_hi(unsigned u) { return __uint_as_float(u & 0xffff0000u); }
DI float bf2f(bf16_t v) { return __uint_as_float(((unsigned)v) << 16); }
DI float siluf(float x) { return x / (1.f + __expf(-x)); }
DI float xch16_max(float x) { const unsigned u = __float_as_uint(x); const u32x2 r = __builtin_amdgcn_permlane16_swap(u, u, false, false); return fmaxf(__uint_as_float(r[0]), __uint_as_float(r[1])); }
DI float xch32_max(float x) { const unsigned u = __float_as_uint(x); const u32x2 r = __builtin_amdgcn_permlane32_swap(u, u, false, false); return fmaxf(__uint_as_float(r[0]), __uint_as_float(r[1])); }
DI float xch16_add(float x) { const unsigned u = __float_as_uint(x); const u32x2 r = __builtin_amdgcn_permlane16_swap(u, u, false, false); return __uint_as_float(r[0]) + __uint_as_float(r[1]); }
DI float xch32_add(float x) { const unsigned u = __float_as_uint(x); const u32x2 r = __builtin_amdgcn_permlane32_swap(u, u, false, false); return __uint_as_float(r[0]) + __uint_as_float(r[1]); }
template <int CTRL> DI float dpp_f(float x) { return __int_as_float(__builtin_amdgcn_update_dpp(0, __float_as_int(x), CTRL, 0xf, 0xf, false)); }
DI float sum4(float x) { x += dpp_f<0xB1>(x); x += dpp_f<0x4E>(x); return x; }
DI float sum16(float x) { x = sum4(x); x += dpp_f<0x141>(x); x += dpp_f<0x140>(x); return x; }
DI f32x4 mfma16(bf16x8 a, bf16x8 b, f32x4 c) { return __builtin_amdgcn_mfma_f32_16x16x32_bf16(a, b, c, 0, 0, 0); }
DI bf16x8 as_bf16x8(u32x4 v) { return __builtin_bit_cast(bf16x8, v); }

namespace pg8 {
constexpr int BM = 256, BK = 64, HALF = 128, HTB = HALF * BK * 2, STAGE_BYTES = 8 * HTB, NXCD = 8, WGM = 8;
DI int lds_byte(int r, int c) { const int st = (r >> 4) * 2 + (c >> 5), rr = r & 15, cc = c & 31, ob = rr * 64 + cc * 2; return st * 1024 + (ob ^ (((ob >> 9) & 1) << 5)); }
DI void stage_rc(int b, int& R, int& C) { const int st = b / 1024, sb = b % 1024, swz = sb ^ (((sb >> 9) & 1) << 5); R = (st >> 1) * 16 + swz / 64; C = (st & 1) * 32 + (swz % 64) / 2; }
DI int perm32(int rho) { const int n = rho >> 4, i = rho & 15; return 8 * (i >> 2) + 4 * n + (i & 3); }
struct Unit { int pm, pn; };
struct Gemm { const bf16_t* A; const bf16_t* Bt; int M, N, K; };
struct StaticOrder {
    int nM, nN, nwg, G, c;
    DI void init(int M, int N, int G_, int c_) { nM = M / BM; nN = N / BM; nwg = nM * nN; G = G_; c = c_; }
    DI bool next(int i, Unit& u) const {
        const long L = (long)i * G + c; if (L >= nwg) return false;
        int wgid = (int)L; { const int q = nwg / NXCD, r = nwg % NXCD, xcd = wgid % NXCD, off = wgid / NXCD; wgid = (xcd < r ? xcd * (q + 1) : r * (q + 1) + (xcd - r) * q) + off; }
        const int nig = WGM * nN, gid = wgid / nig, fm = gid * WGM, gsz = (nM - fm) < WGM ? (nM - fm) : WGM;
        u.pm = fm + ((wgid % nig) % gsz); u.pn = (wgid % nig) / gsz; return true;
    }
};

template <class Epi>
DI void gemm_phase(LAS unsigned char* lds, const Gemm g, const StaticOrder& S, const Epi& E) {
    const int tid = get_tid(), wid = __builtin_amdgcn_readfirstlane(tid >> 6), lane = tid & 63, wr = wid >> 2, wc = wid & 3, fr = lane & 15, fq = lane >> 4;
    const int K = g.K, nt = K / BK;
    unsigned voffA[2], voffB[2];
#pragma unroll
    for (int i = 0; i < 2; ++i) { int R, C; stage_rc(tid * 16 + i * 8192, R, C); const int Rb = Epi::PERM ? ((R & ~31) + perm32(R & 31)) : R;
        voffA[i] = (unsigned)(R * K + C) * 2u; voffB[i] = (unsigned)(Rb * K + C) * 2u; }
    const size_t kstep = (size_t)(BK * 2);
    const size_t hstep = (size_t)HALF * K * 2;
    const size_t tstep = 2 * hstep;
    const unsigned ldsw = (unsigned)wid * 1024u;
    const int aoff = lds_byte(wr * 64 + fr, fq * 8), boff = lds_byte(wc * 32 + fr, fq * 8);
#define PG8_SA(b, h) (((b) * 2 + (h)) * HTB)
#define PG8_SB(b, h) ((4 + (b) * 2 + (h)) * HTB)
#define PG8_STAGE(bufoff, gbase, voff) do { _Pragma("unroll") for (int _i = 0; _i < 2; ++_i) \
        __builtin_amdgcn_global_load_lds((const unsigned*)((const char*)(gbase) + (voff)[_i]), (LAS unsigned*)(lds + (bufoff) + ldsw + _i * 8192), 16, 0, 0); } while (0)
#define PG8_LDA(dst, b, h) do { _Pragma("unroll") for (int m = 0; m < 4; ++m) _Pragma("unroll") for (int k = 0; k < 2; ++k) dst[m][k] = *(const LAS bf16x8*)(lds + PG8_SA(b, h) + aoff + m * 2048 + k * 1024); } while (0)
#define PG8_LDB(dst, b, h) do { _Pragma("unroll") for (int n = 0; n < 2; ++n) _Pragma("unroll") for (int k = 0; k < 2; ++k) dst[n][k] = *(const LAS bf16x8*)(lds + PG8_SB(b, h) + boff + n * 2048 + k * 1024); } while (0)
#define PG8_MMA(ai, bj, At, Bt) do { __builtin_amdgcn_s_setprio(1); _Pragma("unroll") for (int m = 0; m < 4; ++m) _Pragma("unroll") for (int n = 0; n < 2; ++n) _Pragma("unroll") for (int k = 0; k < 2; ++k) \
        acc[ai][bj][m][n] = __builtin_amdgcn_mfma_f32_16x16x32_bf16(Bt[n][k], At[m][k], acc[ai][bj][m][n], 0, 0, 0); __builtin_amdgcn_s_setprio(0); } while (0)
#define PG8_WAIT_V(n) asm volatile("s_waitcnt vmcnt(" #n ")" ::: "memory")
#define PG8_WAIT_L(n) asm volatile("s_waitcnt lgkmcnt(" #n ")" ::: "memory")
#define PG8_BAR __builtin_amdgcn_s_barrier()
#define PG8_SCHED __builtin_amdgcn_sched_barrier(0)
    Unit cur, nxt; int ui = 0;
    if (!S.next(0, cur)) return;
    f32x4 acc[2][2][4][2];
#pragma unroll
    for (int a = 0; a < 2; ++a)
#pragma unroll
        for (int b = 0; b < 2; ++b)
#pragma unroll
            for (int m = 0; m < 4; ++m)
#pragma unroll
                for (int n = 0; n < 2; ++n) acc[a][b][m][n] = (f32x4){0.f, 0.f, 0.f, 0.f};
    bf16x8 At[4][2], B0[2][2], B1[2][2];
    const char* cA = (const char*)g.A + (size_t)cur.pm * tstep; const char* cB = (const char*)g.Bt + (size_t)cur.pn * tstep;
    PG8_STAGE(PG8_SB(0, 0), cB, voffB); PG8_STAGE(PG8_SA(0, 0), cA, voffA); PG8_STAGE(PG8_SB(0, 1), cB + hstep, voffB); PG8_STAGE(PG8_SA(0, 1), cA + hstep, voffA);
    if (wr == 1) PG8_BAR;
    PG8_WAIT_V(4); PG8_BAR;
    PG8_STAGE(PG8_SB(1, 0), cB + kstep, voffB); PG8_STAGE(PG8_SA(1, 0), cA + kstep, voffA); PG8_STAGE(PG8_SB(1, 1), cB + hstep + kstep, voffB);
    PG8_WAIT_V(6); PG8_BAR;
    for (;;) {
        const bool has_next = S.next(ui + 1, nxt);
        const char* nA = has_next ? (const char*)g.A + (size_t)nxt.pm * tstep : cA; const char* nB = has_next ? (const char*)g.Bt + (size_t)nxt.pn * tstep : cB;
        for (int t = 0; t < nt; t += 2) {
            const bool last = (t == nt - 2);
            const char* a1 = cA + (size_t)(t + 1) * kstep;
            const char* a2 = last ? nA : cA + (size_t)(t + 2) * kstep; const char* b2 = last ? nB : cB + (size_t)(t + 2) * kstep;
            const char* a3 = a2 + kstep; const char* b3 = b2 + kstep;
            PG8_LDB(B0, 0, 0); PG8_SCHED; PG8_LDA(At, 0, 0); PG8_STAGE(PG8_SA(1, 1), a1 + hstep, voffA);
            PG8_WAIT_L(8); PG8_BAR; PG8_WAIT_L(0); PG8_MMA(0, 0, At, B0); PG8_BAR; PG8_SCHED;
            PG8_LDB(B1, 0, 1); PG8_STAGE(PG8_SB(0, 0), b2, voffB);
            PG8_BAR; PG8_WAIT_L(0); PG8_MMA(0, 1, At, B1); PG8_BAR;
            PG8_LDA(At, 0, 1); PG8_STAGE(PG8_SA(0, 0), a2, voffA);
            PG8_BAR; PG8_WAIT_L(0); PG8_MMA(1, 0, At, B0); PG8_BAR; PG8_SCHED;
            PG8_STAGE(PG8_SB(0, 1), b2 + hstep, voffB);
            PG8_WAIT_V(6); PG8_BAR; PG8_MMA(1, 1, At, B1); PG8_BAR;
            PG8_LDB(B0, 1, 0); PG8_SCHED; PG8_LDA(At, 1, 0); PG8_STAGE(PG8_SA(0, 1), a2 + hstep, voffA);
            PG8_WAIT_L(8); PG8_BAR; PG8_WAIT_L(0); PG8_MMA(0, 0, At, B0); PG8_BAR; PG8_SCHED;
            PG8_LDB(B1, 1, 1); PG8_STAGE(PG8_SB(1, 0), b3, voffB);
            PG8_BAR; PG8_WAIT_L(0); PG8_MMA(0, 1, At, B1); PG8_BAR;
            PG8_LDA(At, 1, 1); PG8_STAGE(PG8_SA(1, 0), a3, voffA);
            PG8_BAR; PG8_WAIT_L(0); PG8_MMA(1, 0, At, B0); PG8_BAR; PG8_SCHED;
            PG8_STAGE(PG8_SB(1, 1), b3 + hstep, voffB);
            PG8_WAIT_V(6); PG8_BAR; PG8_MMA(1, 1, At, B1); PG8_BAR;
        }
        E(acc, cur, wr, wc, fr, fq);
        if (!has_next) break;
#pragma unroll
        for (int a = 0; a < 2; ++a)
#pragma unroll
            for (int b = 0; b < 2; ++b)
#pragma unroll
                for (int m = 0; m < 4; ++m)
#pragma unroll
                    for (int n = 0; n < 2; ++n) acc[a][b][m][n] = (f32x4){0.f, 0.f, 0.f, 0.f};
        cur = nxt; cA = nA; cB = nB; ++ui;
    }
    PG8_WAIT_V(0);
    if (wr == 0) PG8_BAR;
    PG8_BAR;
#undef PG8_SA
#undef PG8_SB
#undef PG8_STAGE
#undef PG8_LDA
#undef PG8_LDB
#undef PG8_MMA
#undef PG8_WAIT_V
#undef PG8_WAIT_L
#undef PG8_BAR
#undef PG8_SCHED
}
}

struct EpiProj {
    static constexpr bool PERM = true;
    bf16_t* proj; float* small;
    DI void operator()(const f32x4 (&acc)[2][2][4][2], const pg8::Unit& u, int wr, int wc, int fr, int fq) const {
        const int row0 = u.pm * 256 + wr * 64 + fr;
        if (u.pn < 30) {
            const int col0 = u.pn * 256 + wc * 32 + 8 * fq;
#pragma unroll
            for (int ai = 0; ai < 2; ++ai)
#pragma unroll
                for (int m = 0; m < 4; ++m) {
                    bf16_t* rowp = proj + (size_t)(row0 + ai * 128 + m * 16) * NPROJ + col0;
#pragma unroll
                    for (int bj = 0; bj < 2; ++bj) {
                        const f32x4 v0 = acc[ai][bj][m][0], v1 = acc[ai][bj][m][1];
                        u32x4 w; w.x = cvt_pk_bf16(v0[0], v0[1]); w.y = cvt_pk_bf16(v0[2], v0[3]); w.z = cvt_pk_bf16(v1[0], v1[1]); w.w = cvt_pk_bf16(v1[2], v1[3]);
                        *(u32x4*)(rowp + bj * 128) = w;
                    }
                }
        } else if (wc == 0) {
#pragma unroll
            for (int ai = 0; ai < 2; ++ai)
#pragma unroll
                for (int m = 0; m < 4; ++m) {
                    float* rowp = small + (size_t)(row0 + ai * 128 + m * 16) * 32 + 8 * fq;
                    *(f32x4*)(rowp) = acc[ai][0][m][0]; *(f32x4*)(rowp + 4) = acc[ai][0][m][1];
                }
        }
    }
};
struct EpiOut {
    static constexpr bool PERM = false;
    const float* xin; float* xout; const float* gate;
    DI void operator()(const f32x4 (&acc)[2][2][4][2], const pg8::Unit& u, int wr, int wc, int fr, int fq) const {
        const int row0 = u.pm * 256 + wr * 64 + fr, col0 = u.pn * 256 + wc * 32 + 4 * fq;
        const int b = (u.pm * 256) >> 11;
        f32x4 g[2][2];
#pragma unroll
        for (int bj = 0; bj < 2; ++bj)
#pragma unroll
            for (int n = 0; n < 2; ++n) g[bj][n] = *(const f32x4*)(gate + b * 6144 + col0 + bj * 128 + n * 16);
#pragma unroll
        for (int ai = 0; ai < 2; ++ai)
#pragma unroll
            for (int mh = 0; mh < 2; ++mh) {
                f32x4 xv[2][2][2];
#pragma unroll
                for (int mm = 0; mm < 2; ++mm)
#pragma unroll
                    for (int bj = 0; bj < 2; ++bj)
#pragma unroll
                        for (int n = 0; n < 2; ++n)
                            xv[mm][bj][n] = *(const f32x4*)(xin + (size_t)(row0 + ai * 128 + (2 * mh + mm) * 16) * DM + col0 + bj * 128 + n * 16);
#pragma unroll
                for (int mm = 0; mm < 2; ++mm)
#pragma unroll
                    for (int bj = 0; bj < 2; ++bj)
#pragma unroll
                        for (int n = 0; n < 2; ++n)
                            *(f32x4*)(xout + (size_t)(row0 + ai * 128 + (2 * mh + mm) * 16) * DM + col0 + bj * 128 + n * 16) = xv[mm][bj][n] + g[bj][n] * acc[ai][bj][2 * mh + mm][n];
            }
    }
};

DI int orig_col(int j) {
    if (j < 1024) return j;
    if (j < 3072) return j + 16;
    if (j < 7680) return j + 24;
    if (j < 7696) return 1024 + (j - 7680);
    if (j < 7704) return 3088 + (j - 7696);
    return -1;
}
DI void transpose_tile(const float* src, int ldsrc, bf16_t* dst, int n0, int k0, bool remap, float* tile) {
    const int tid = get_tid(), nn = tid & 63, kb = tid >> 6;
    const int n = n0 + nn, oc = remap ? orig_col(n) : n;
    float v[32];
#pragma unroll
    for (int i = 0; i < 32; ++i) v[i] = oc >= 0 ? __builtin_nontemporal_load(src + (size_t)(k0 + kb + 8 * i) * ldsrc + oc) : 0.f;
#pragma unroll
    for (int i = 0; i < 32; ++i) tile[(kb + 8 * i) * 65 + nn] = v[i];
    __syncthreads();
    const int r = tid >> 3, seg = tid & 7;
#pragma unroll
    for (int half = 0; half < 2; ++half) {
        unsigned pk[8];
#pragma unroll
        for (int j = 0; j < 8; ++j) pk[j] = cvt_pk_bf16(tile[(half * 128 + seg * 16 + 2 * j) * 65 + r], tile[(half * 128 + seg * 16 + 2 * j + 1) * 65 + r]);
        u32x4* d = (u32x4*)(dst + (size_t)(n0 + r) * 2048 + k0 + half * 128 + seg * 16);
        d[0] = (u32x4){pk[0], pk[1], pk[2], pk[3]}; d[1] = (u32x4){pk[4], pk[5], pk[6], pk[7]};
    }
    __syncthreads();
}
DI void adaln_item(const Params& p, int l, int cgp, float* lds) {
    const int tid = get_tid(), w = tid >> 6, lane = tid & 63;
    for (int i = tid; i < 8192; i += 512) { const float cv = p.c[i]; lds[i] = cv / (1.f + expf(-cv)); }
    __syncthreads();
    const int col = cgp * 64 + lane;
    const float* wp = p.w_ada + (size_t)l * 2048 * 6144 + col;
    float a0 = 0.f, a1 = 0.f, a2 = 0.f, a3 = 0.f;
    for (int k = w * 256; k < w * 256 + 256; k += 64) {
        float wv[64];
#pragma unroll
        for (int j = 0; j < 64; ++j) wv[j] = __builtin_nontemporal_load(wp + (size_t)(k + j) * 6144);
#pragma unroll
        for (int j = 0; j < 64; ++j) { a0 += lds[k + j] * wv[j]; a1 += lds[2048 + k + j] * wv[j]; a2 += lds[4096 + k + j] * wv[j]; a3 += lds[6144 + k + j] * wv[j]; }
    }
    float* red = lds + 8192;
    red[(w * 4 + 0) * 64 + lane] = a0; red[(w * 4 + 1) * 64 + lane] = a1; red[(w * 4 + 2) * 64 + lane] = a2; red[(w * 4 + 3) * 64 + lane] = a3;
    __syncthreads();
    if (tid < 256) {
        const int b = tid >> 6; float s = 0.f;
#pragma unroll
        for (int ww = 0; ww < 8; ++ww) s += red[(ww * 4 + b) * 64 + lane];
        p.mod[(size_t)(l * 4 + b) * 6144 + col] = s + p.b_ada[l * 6144 + col];
    }
    __syncthreads();
}
DI void phase0(const Params& p, float* lds) {
    const int tid = get_tid();
    const int bid = get_bid();
    if (bid == 0 && tid < 64) p.cnt[tid] = 0u;
    if (bid == 1 && tid < 2) {
        const float* lv = p.diff_lambda + tid * 512; float s1 = 0.f, s2 = 0.f;
        for (int i = 0; i < 128; ++i) { s1 += lv[i] * lv[128 + i]; s2 += lv[256 + i] * lv[384 + i]; }
        const float lam_init = 0.8f - 0.6f * expf(-0.3f * (float)tid);
        p.lam[tid] = expf(s1) - expf(s2) + lam_init;
    }
    constexpr int N_ADA = 192, N_ROPE = 128, N_WIN = 124 * 8, N_WOUT = 32 * 8;
    constexpr int N_ITEMS = N_ADA + N_ROPE + 2 * (N_WIN + N_WOUT);
    for (int it = bid; it < N_ITEMS; it += gridDim.x) {
        if (it < N_ADA) { adaln_item(p, it / 96, it % 96, lds); }
        else if (it < N_ADA + N_ROPE) {
            const int t0 = (it - N_ADA) * 64;
            for (int e = tid; e < 64 * 64; e += 512) {
                const int t = t0 + (e >> 6), i = e & 63;
                const float inv = powf(10000.0f, -(float)i / 64.0f);
                const float ang = (float)p.pos[t] * inv;
                p.rope[(size_t)t * 128 + i] = cosf(ang); p.rope[(size_t)t * 128 + 64 + i] = sinf(ang);
            }
        } else {
            int j = it - N_ADA - N_ROPE; const int l = j / (N_WIN + N_WOUT); j -= l * (N_WIN + N_WOUT);
            if (j < N_WIN) transpose_tile(p.w_in + (size_t)l * 2048 * DIN, DIN, p.WinT + (size_t)l * NPAD * 2048, (j >> 3) * 64, (j & 7) * 256, true, lds);
            else { j -= N_WIN; transpose_tile(p.w_out + (size_t)l * 2048 * 2048, 2048, p.WoutT + (size_t)l * 2048 * 2048, (j >> 3) * 64, (j & 7) * 256, false, lds); }
        }
    }
}

DI void phase1(const Params& p, int l, const float* xin) {
    const int tid = get_tid(), w = tid >> 6, lane = tid & 63;
    const int nwav = gridDim.x * 8;
    for (int q = get_bid() * 8 + w; q < TT / 2; q += nwav) {
        const int b = q >> 10, r0 = b * 2048 + (q & 1023);
        const float* md = p.mod + (size_t)(l * 4 + b) * 6144;
        f32x4 v[2][8], nw[8], sh[8], sc[8];
#pragma unroll
        for (int u = 0; u < 2; ++u)
#pragma unroll
            for (int i = 0; i < 8; ++i) v[u][i] = *(const f32x4*)(xin + (size_t)(r0 + u * 1024) * DM + i * 256 + lane * 4);
#pragma unroll
        for (int i = 0; i < 8; ++i) {
            const int col = i * 256 + lane * 4;
            nw[i] = *(const f32x4*)(p.norm_w + l * 2048 + col); sh[i] = *(const f32x4*)(md + col); sc[i] = *(const f32x4*)(md + 2048 + col);
        }
        float ss[2] = {0.f, 0.f};
#pragma unroll
        for (int u = 0; u < 2; ++u) {
#pragma unroll
            for (int i = 0; i < 8; ++i) ss[u] += v[u][i][0] * v[u][i][0] + v[u][i][1] * v[u][i][1] + v[u][i][2] * v[u][i][2] + v[u][i][3] * v[u][i][3];
            ss[u] = sum16(ss[u]); ss[u] = xch16_add(ss[u]); ss[u] = xch32_add(ss[u]);
        }
#pragma unroll
        for (int u = 0; u < 2; ++u) {
            const float rstd = rsqrtf(ss[u] * (1.f / 2048.f) + 1e-6f);
#pragma unroll
            for (int i = 0; i < 8; ++i) {
                const f32x4 y = v[u][i] * rstd * nw[i] * (1.f + sc[i]) + sh[i];
                u32x2 o; o.x = cvt_pk_bf16(y[0], y[1]); o.y = cvt_pk_bf16(y[2], y[3]);
                *(u32x2*)(p.hbuf + (size_t)(r0 + u * 1024) * DM + i * 256 + lane * 4) = o;
            }
        }
    }
}

DI void gdn_prep(const Params& p, int l, int ci, unsigned char* lds, int stop) {
    const int tid = get_tid(), w = tid >> 6, lane = tid & 63, fr = lane & 15, q4 = lane >> 4;
    const int n = ci & 31, h = (ci >> 5) & 3, b = ci >> 7;
    const int t0 = b * SEQ + n * 64;
    constexpr int FS = 129;
    float* gcs = (float*)lds;
    float* bet = gcs + 64;
    float* rn = bet + 64;
    float* eg = rn + 128;
    float* egl = eg + 64;
    float* qf = egl + 64;
    float* kf = qf + 64 * FS;
    float* vf = kf + 64 * FS;
    float* Lm = vf + 64 * FS;
    bf16_t* qb = (bf16_t*)(Lm + 64 * 64);
    bf16_t* kb = qb + 64 * 136;
    bf16_t* raw = (bf16_t*)Lm;
    float cwt[3][4];
#pragma unroll
    for (int r = 0; r < 3; ++r) {
        const int chn = (tid + r * 512) % 384, seg = chn >> 7, d = chn & 127;
        const float* cw = p.gdn_conv_w + (size_t)l * 4 * 1536 + seg * 512 + h * 128 + d;
        cwt[r][0] = cw[0]; cwt[r][1] = cw[1536]; cwt[r][2] = cw[2 * 1536]; cwt[r][3] = cw[3 * 1536];
    }
    {
        u32x4 sv[7];
#pragma unroll
        for (int i = 0; i < 7; ++i) {
            const int e = tid + i * 512;
            const int row = e / 48, rem = e - row * 48, seg = rem >> 4, ch = rem & 15;
            sv[i] = (u32x4){0u, 0u, 0u, 0u};
            if (e < 67 * 48 && (n > 0 || row >= 3)) sv[i] = __builtin_nontemporal_load((const u32x4*)(p.proj + (size_t)(t0 - 3 + row) * NPROJ + 1536 + seg * 512 + h * 128 + ch * 8));
        }
#pragma unroll
        for (int i = 0; i < 7; ++i) {
            const int e = tid + i * 512;
            const int row = e / 48, rem = e - row * 48, seg = rem >> 4, ch = rem & 15;
            if (e < 67 * 48) *(u32x4*)(raw + row * 384 + seg * 128 + ch * 8) = sv[i];
        }
    }
    if (tid < 64) {
        const int c = tid;
        const float da = p.small[(size_t)(t0 + c) * 32 + 16 + h], db = p.small[(size_t)(t0 + c) * 32 + 20 + h];
        const float xx = da + p.gdn_dt_bias[l * 4 + h];
        const float sp = xx > 20.f ? xx : log1pf(expf(xx));
        gcs[c] = -expf(p.gdn_a_log[l * 4 + h]) * sp;
        bet[c] = 1.f / (1.f + expf(-db));
    }
    __syncthreads();
#pragma unroll
    for (int r = 0; r < 3; ++r) {
        const int task = tid + r * 512;
        const int chn = task % 384, qt = task / 384;
        const int seg = chn >> 7, d = chn & 127;
        const float w0 = cwt[r][0], w1 = cwt[r][1], w2 = cwt[r][2], w3 = cwt[r][3];
        const bf16_t* rp = raw + (qt * 16) * 384 + seg * 128 + d;
        float xs[19];
#pragma unroll
        for (int c = 0; c < 19; ++c) xs[c] = bf2f(rp[c * 384]);
        float* dst = (seg == 0 ? qf : (seg == 1 ? kf : vf)) + (qt * 16) * FS + d;
#pragma unroll
        for (int c = 0; c < 16; ++c) {
            const float a = w0 * xs[c] + w1 * xs[c + 1] + w2 * xs[c + 2] + w3 * xs[c + 3];
            dst[c * FS] = a * __builtin_amdgcn_rcpf(1.f + __expf(-a));
        }
    }
    __syncthreads();
    if (stop == 1) return;
    {
        const int row = tid >> 2, sub = tid & 3;
        const float* src = (row < 64 ? qf + row * FS : kf + (row - 64) * FS);
        float s = 0.f;
        for (int i = 0; i < 32; ++i) { const float v = src[sub + 4 * i]; s += v * v; }
        s = sum4(s);
        if (sub == 0) rn[row] = rsqrtf(s + 1e-6f);
    }
    float gsum = 0.f;
    if (tid < 64) {
        gsum = gcs[tid];
#pragma unroll
        for (int o = 1; o < 64; o <<= 1) { const float t = __shfl_up(gsum, o); if (lane >= o) gsum += t; }
    }
    __syncthreads();
    if (tid < 64) gcs[tid] = gsum;
    { const float glast = __shfl(gsum, 63); if (tid < 64) { eg[tid] = __expf(gsum); egl[tid] = __expf(glast - gsum); } }
    for (int e = tid; e < 64 * 128; e += 512) {
        const int c = e >> 7, d = e & 127;
        const float qv = qf[c * FS + d] * rn[c] * 0.08838834764831845f, kv = kf[c * FS + d] * rn[64 + c];
        qf[c * FS + d] = qv; kf[c * FS + d] = kv;
        qb[c * 136 + d] = (bf16_t)(cvt_pk_bf16(qv, 0.f) & 0xffffu); kb[c * 136 + d] = (bf16_t)(cvt_pk_bf16(kv, 0.f) & 0xffffu);
    }
    __syncthreads();
    {
        const int ct = w >> 1;
        const int c = ct * 16 + fr;
        const float gc_c = gcs[c], be_c = bet[c];
#pragma unroll
        for (int i = 0; i < 2; ++i) {
            const int st = (w & 1) * 2 + i;
            f32x4 akk = {0.f, 0.f, 0.f, 0.f}, aqk = {0.f, 0.f, 0.f, 0.f};
            if (st <= ct) {
#pragma unroll
                for (int ks = 0; ks < 4; ++ks) {
                    const bf16x8 ak = *(const bf16x8*)(kb + (st * 16 + fr) * 136 + ks * 32 + q4 * 8);
                    const bf16x8 bk = *(const bf16x8*)(kb + (ct * 16 + fr) * 136 + ks * 32 + q4 * 8);
                    const bf16x8 bq = *(const bf16x8*)(qb + (ct * 16 + fr) * 136 + ks * 32 + q4 * 8);
                    akk = mfma16(ak, bk, akk); aqk = mfma16(ak, bq, aqk);
                }
            }
            f32x4 lv, qv;
#pragma unroll
            for (int r = 0; r < 4; ++r) {
                const int s = st * 16 + q4 * 4 + r;
                const float dec = (s <= c) ? __expf(gc_c - gcs[s]) : 0.f;
                lv[r] = (s < c) ? be_c * akk[r] * dec : 0.f;
                qv[r] = aqk[r] * dec;
            }
            *(f32x4*)(Lm + c * 64 + st * 16 + q4 * 4) = lv;
            u32x2 o; o.x = cvt_pk_bf16(qv[0], qv[1]); o.y = cvt_pk_bf16(qv[2], qv[3]);
            *(u32x2*)(p.dqk + (size_t)ci * 4096 + c * 64 + st * 16 + q4 * 4) = o;
        }
    }
    __syncthreads();
    if (stop == 2) { __syncthreads(); return; }
    if (tid >= 256) {
        const int t2 = tid - 256;
#pragma unroll
        for (int i = 0; i < 4; ++i) {
            const int e = t2 + i * 256; const int c = e >> 4, d = (e & 15) * 8; const float egc = eg[c];
            const u32x4 r = *(const u32x4*)(qb + c * 136 + d);
            u32x4 o; o.x = cvt_pk_bf16(bf_lo(r.x) * egc, bf_hi(r.x) * egc); o.y = cvt_pk_bf16(bf_lo(r.y) * egc, bf_hi(r.y) * egc);
            o.z = cvt_pk_bf16(bf_lo(r.z) * egc, bf_hi(r.z) * egc); o.w = cvt_pk_bf16(bf_lo(r.w) * egc, bf_hi(r.w) * egc);
            *(u32x4*)(p.dqe + (size_t)ci * 8192 + c * 128 + d) = o;
        }
#pragma unroll
        for (int i = 0; i < 4; ++i) {
            const int e = t2 + i * 256; const int d = e & 127, c = (e >> 7) * 8;
            float kv[8];
#pragma unroll
            for (int j = 0; j < 8; ++j) kv[j] = bf2f(kb[(c + j) * 136 + d]) * egl[c + j];
            u32x4 o; o.x = cvt_pk_bf16(kv[0], kv[1]); o.y = cvt_pk_bf16(kv[2], kv[3]); o.z = cvt_pk_bf16(kv[4], kv[5]); o.w = cvt_pk_bf16(kv[6], kv[7]);
            *(u32x4*)(p.dktT + (size_t)ci * 8192 + d * 64 + c) = o;
        }
        if (t2 == 0) p.dcd[ci] = eg[63];
    } else if (stop != 3) {
        const int j = tid & 127; const bool isw = tid >= 128;
        float* X = (isw ? kf : vf) + j;
        int zoff; asm volatile("v_mov_b32 %0, 0" : "=v"(zoff));
        const float* Lz = Lm + zoff;
#pragma unroll 1
        for (int rb = 0; rb < 4; ++rb) {
            float a[16];
#pragma unroll
            for (int r = 0; r < 16; ++r) { const int i = rb * 16 + r; float v = X[i * FS] * bet[i]; if (isw) v *= eg[i]; a[r] = v; }
#pragma unroll 1
            for (int j4 = 0; j4 < rb * 4; ++j4) {
                const float x0 = X[(j4 * 4 + 0) * FS], x1 = X[(j4 * 4 + 1) * FS], x2 = X[(j4 * 4 + 2) * FS], x3 = X[(j4 * 4 + 3) * FS];
#pragma unroll
                for (int r = 0; r < 16; ++r) {
                    const f32x4 lv = *(const f32x4*)(Lz + (rb * 16 + r) * 64 + j4 * 4);
                    a[r] -= lv[0] * x0; a[r] -= lv[1] * x1; a[r] -= lv[2] * x2; a[r] -= lv[3] * x3;
                }
            }
#pragma unroll
            for (int r = 1; r < 16; ++r) {
#pragma unroll
                for (int r2 = 0; r2 < r; ++r2) a[r] -= Lz[(rb * 16 + r) * 64 + rb * 16 + r2] * a[r2];
            }
#pragma unroll
            for (int r = 0; r < 16; ++r) X[(rb * 16 + r) * FS] = a[r];
            if (!isw) {
#pragma unroll
                for (int r = 0; r < 16; ++r) p.du[(size_t)ci * 8192 + (rb * 16 + r) * 128 + j] = a[r];
            } else {
#pragma unroll
                for (int r = 0; r < 16; ++r) p.dw[(size_t)ci * 8192 + (rb * 16 + r) * 128 + j] = (bf16_t)(cvt_pk_bf16(a[r], 0.f) & 0xffffu);
            }
        }
    }
    __syncthreads();
}

DI void gla_prep(const Params& p, int l, int bn, unsigned char* lds) {
    const int tid = get_tid(), w = tid >> 6, lane = tid & 63, fr = lane & 15, q4 = lane >> 4;
    const int n = bn & 31, b = bn >> 5;
    const int t0 = b * SEQ + n * 64;
    float* glr = (float*)lds;
    float* bcum = glr + 64 * 16;
    bf16_t* qe_s = (bf16_t*)(bcum + 64 * 256);
    bf16_t* ke_s = qe_s + 64 * 72;
    bf16_t* kdT_s = ke_s + 64 * 72;
    bf16_t* vT_s = kdT_s + 64 * 72;
    u32x4 qr4[4], kr4[4], va4[4], vb4[4];
    {
        const int c = tid >> 3, ds = (tid & 7) * 8, dv0 = (tid & 7) * 16;
        const bf16_t* rowp = p.proj + (size_t)(t0 + c) * NPROJ;
#pragma unroll
        for (int h = 0; h < 4; ++h) {
            qr4[h] = __builtin_nontemporal_load((const u32x4*)(rowp + h * 64 + ds)); kr4[h] = __builtin_nontemporal_load((const u32x4*)(rowp + 256 + h * 64 + ds));
            va4[h] = __builtin_nontemporal_load((const u32x4*)(rowp + 512 + h * 128 + dv0)); vb4[h] = __builtin_nontemporal_load((const u32x4*)(rowp + 512 + h * 128 + dv0 + 8));
        }
    }
    float wl[16]; float bl;
#pragma unroll
    for (int r = 0; r < 16; ++r) wl[r] = p.gla_w_lr[(size_t)l * 16 * 256 + r * 256 + (tid & 255)];
    bl = p.gla_b_lr[l * 256 + (tid & 255)];
    if (tid < 256) { const int c = tid >> 2, r4 = (tid & 3) * 4; *(f32x4*)(glr + c * 16 + r4) = *(const f32x4*)(p.small + (size_t)(t0 + c) * 32 + r4); }
    __syncthreads();
    {
        const int col = tid & 255, c0 = (tid >> 8) * 32;
        float run = 0.f;
#pragma unroll 4
        for (int c = c0; c < c0 + 32; ++c) {
            float z = bl;
#pragma unroll
            for (int r = 0; r < 16; ++r) z += glr[c * 16 + r] * wl[r];
            const float la = (fminf(z, 0.f) - __logf(1.f + __expf(-fabsf(z)))) * (1.f / 16.f);
            run += la; bcum[c * 256 + col] = run;
        }
    }
    __syncthreads();
#pragma unroll
    for (int h = 0; h < 4; ++h) {
        const int ci = (b * 4 + h) * 32 + n;
        bf16_t* qe_h = qe_s + (h & 1) * 23040;
        bf16_t* ke_h = qe_h + 64 * 72;
        bf16_t* kdT_h = ke_h + 64 * 72;
        bf16_t* vT_h = kdT_h + 64 * 72;
        {
            const int c = tid >> 3, ds = (tid & 7) * 8, sw = (tid & 7) * 8;
            const u32x4 qr = qr4[h];
            const u32x4 kr = kr4[h];
            float qv[8], kv[8], bv[8], bl8[8];
#pragma unroll
            for (int j = 0; j < 4; ++j) { qv[2 * j] = bf_lo(qr[j]); qv[2 * j + 1] = bf_hi(qr[j]); kv[2 * j] = bf_lo(kr[j]); kv[2 * j + 1] = bf_hi(kr[j]); }
#pragma unroll
            for (int j = 0; j < 8; ++j) {
                const float t1 = bcum[31 * 256 + h * 64 + ds + j];
                bv[j] = bcum[c * 256 + h * 64 + ds + j] + (c >= 32 ? t1 : 0.f);
                bl8[j] = bcum[63 * 256 + h * 64 + ds + j] + t1;
            }
            u32x4 qo, ko;
#pragma unroll
            for (int j = 0; j < 4; ++j) {
                qo[j] = cvt_pk_bf16(qv[2 * j] * 0.125f * __expf(bv[2 * j]), qv[2 * j + 1] * 0.125f * __expf(bv[2 * j + 1]));
                ko[j] = cvt_pk_bf16(kv[2 * j] * __expf(-bv[2 * j]), kv[2 * j + 1] * __expf(-bv[2 * j + 1]));
            }
            *(u32x4*)(qe_h + c * 72 + ds) = qo; *(u32x4*)(ke_h + c * 72 + ds) = ko;
            *(u32x4*)(p.gqe + (size_t)ci * 4096 + c * 64 + ds) = qo;
#pragma unroll
            for (int j = 0; j < 8; ++j) kdT_h[(ds + j) * 72 + (c ^ sw)] = (bf16_t)(cvt_pk_bf16(kv[j] * __expf(bl8[j] - bv[j]), 0.f) & 0xffffu);
            const int dv0 = (tid & 7) * 16;
            const u32x4 v0 = va4[h];
            const u32x4 v1 = vb4[h];
#pragma unroll
            for (int j = 0; j < 4; ++j) {
                vT_h[(dv0 + 2 * j) * 72 + (c ^ sw)] = (bf16_t)(v0[j] & 0xffffu); vT_h[(dv0 + 2 * j + 1) * 72 + (c ^ sw)] = (bf16_t)(v0[j] >> 16);
                vT_h[(dv0 + 8 + 2 * j) * 72 + (c ^ sw)] = (bf16_t)(v1[j] & 0xffffu); vT_h[(dv0 + 8 + 2 * j + 1) * 72 + (c ^ sw)] = (bf16_t)(v1[j] >> 16);
            }
            if (tid < 64) p.gdec[(size_t)ci * 64 + tid] = __expf(bcum[63 * 256 + h * 64 + tid] + bcum[31 * 256 + h * 64 + tid]);
        }
        __syncthreads();
#pragma unroll
        for (int i = 0; i < 2; ++i) {
            const int id = w * 2 + i, ct = id >> 2, st = id & 3;
            f32x4 a = {0.f, 0.f, 0.f, 0.f};
            if (st <= ct) {
#pragma unroll
                for (int ks = 0; ks < 2; ++ks) {
                    const bf16x8 ak = *(const bf16x8*)(ke_h + (st * 16 + fr) * 72 + ks * 32 + q4 * 8);
                    const bf16x8 bq = *(const bf16x8*)(qe_h + (ct * 16 + fr) * 72 + ks * 32 + q4 * 8);
                    a = mfma16(ak, bq, a);
                }
            }
            const int c = ct * 16 + fr;
#pragma unroll
            for (int r = 0; r < 4; ++r) { const int s2 = st * 16 + q4 * 4 + r; if (s2 > c) a[r] = 0.f; }
            u32x2 o; o.x = cvt_pk_bf16(a[0], a[1]); o.y = cvt_pk_bf16(a[2], a[3]);
            *(u32x2*)(p.gatt + (size_t)ci * 4096 + c * 64 + st * 16 + q4 * 4) = o;
        }
        {
            const int r = tid >> 3, cs = (tid & 7) * 8;
            *(u32x4*)(p.gkdT + (size_t)ci * 4096 + r * 64 + cs) = *(const u32x4*)(kdT_h + r * 72 + (cs ^ (((r >> 3) & 7) * 8)));
            *(u32x4*)(p.gvT + (size_t)ci * 8192 + r * 64 + cs) = *(const u32x4*)(vT_h + r * 72 + (cs ^ (((r >> 4) & 7) * 8)));
            *(u32x4*)(p.gvT + (size_t)ci * 8192 + (64 + r) * 64 + cs) = *(const u32x4*)(vT_h + (64 + r) * 72 + (cs ^ ((((64 + r) >> 4) & 7) * 8)));
        }
    }
    __syncthreads();
}

DI void diff_prep(const Params& p, int l, int tile, unsigned char* lds) {
    const int tid = get_tid();
    const int t0 = tile * 64, b = t0 >> 11, s0 = t0 & 2047;
    bf16_t* vs = (bf16_t*)lds;
    {
        const int g = tid >> 4, i16 = tid & 15;
        const int d0 = i16 * 8, fi = (i16 & 7) * 8;
        float qw[8], kw[8];
#pragma unroll
        for (int j = 0; j < 8; ++j) { qw[j] = p.diff_q_norm_w[l * 128 + d0 + j]; kw[j] = p.diff_k_norm_w[l * 128 + d0 + j]; }
#pragma unroll 1
        for (int pass = 0; pass < 2; ++pass) {
            const int tk = pass * 32 + g, t = t0 + tk;
            const f32x4 cs0 = *(const f32x4*)(p.rope + (size_t)t * 128 + fi), cs1 = *(const f32x4*)(p.rope + (size_t)t * 128 + fi + 4);
            const f32x4 sn0 = *(const f32x4*)(p.rope + (size_t)t * 128 + 64 + fi), sn1 = *(const f32x4*)(p.rope + (size_t)t * 128 + 64 + fi + 4);
            u32x4 vreg[8];
#pragma unroll
            for (int i = 0; i < 8; ++i) { const int e = tid + (pass * 8 + i) * 512; vreg[i] = __builtin_nontemporal_load((const u32x4*)(p.proj + (size_t)(t0 + (e >> 7)) * NPROJ + 5632 + (e & 127) * 8)); }
            u32x4 raw16[16];
#pragma unroll
            for (int vec = 0; vec < 16; ++vec) raw16[vec] = __builtin_nontemporal_load((const u32x4*)(p.proj + (size_t)t * NPROJ + 3584 + vec * 128 + d0));
#pragma unroll
            for (int i = 0; i < 8; ++i) { const int e = tid + (pass * 8 + i) * 512; *(u32x4*)(vs + (e >> 7) * 1032 + (e & 127) * 8) = vreg[i]; }
#pragma unroll
            for (int vec = 0; vec < 16; ++vec) {
                const int isk = vec >> 3, hm = vec & 7;
                float v[8];
#pragma unroll
                for (int j = 0; j < 4; ++j) { v[2 * j] = bf_lo(raw16[vec][j]); v[2 * j + 1] = bf_hi(raw16[vec][j]); }
                float ss = 0.f;
#pragma unroll
                for (int j = 0; j < 8; ++j) ss += v[j] * v[j];
                ss = sum16(ss);
                const float rstd = rsqrtf(ss * (1.f / 128.f) + 1e-6f);
                const float sc = isk ? 1.f : 0.08838834764831845f * 1.4426950408889634f;
                float o[8];
#pragma unroll
                for (int j = 0; j < 8; ++j) {
                    const float y = v[j] * rstd * (isk ? kw[j] : qw[j]);
                    const float oth = dpp_f<0x128>(y);
                    const float cs = (j < 4 ? cs0 : cs1)[j & 3], sn = (j < 4 ? sn0 : sn1)[j & 3];
                    o[j] = ((i16 < 8) ? (y * cs - oth * sn) : (y * cs + oth * sn)) * sc;
                }
                u32x4 ov; ov.x = cvt_pk_bf16(o[0], o[1]); ov.y = cvt_pk_bf16(o[2], o[3]); ov.z = cvt_pk_bf16(o[4], o[5]); ov.w = cvt_pk_bf16(o[6], o[7]);
                bf16_t* dst = (isk ? p.kd : p.qd) + ((size_t)((b * 8 + hm) * SEQ + s0 + tk)) * 128 + d0;
                *(u32x4*)dst = ov;
            }
        }
    }
    __syncthreads();
    {
        const int c2 = tid * 2, hh = c2 >> 8, dv = c2 & 255;
        bf16_t* dst = p.vT + ((size_t)((b * 4 + hh) * 32 + (s0 >> 6)) * 256 + dv) * 64;
#pragma unroll
        for (int seg = 0; seg < 8; ++seg) {
            unsigned wv[8];
#pragma unroll
            for (int j = 0; j < 8; ++j) wv[j] = *(const unsigned*)(vs + (seg * 8 + j) * 1032 + c2);
            u32x4 r0, r1;
#pragma unroll
            for (int j = 0; j < 4; ++j) { r0[j] = (wv[2 * j] & 0xffffu) | (wv[2 * j + 1] << 16); r1[j] = (wv[2 * j] >> 16) | (wv[2 * j + 1] & 0xffff0000u); }
            *(u32x4*)(dst + seg * 8) = r0; *(u32x4*)(dst + 64 + seg * 8) = r1;
        }
    }
    __syncthreads();
}

DI void phase3(const Params& p, int l, unsigned char* lds, int mask, int stop) {
    for (int it = get_bid(); it < 768; it += gridDim.x) {
        if (it < 512) { if (mask & 1) gdn_prep(p, l, it, lds, stop); }
        else if (it < 640) { if (mask & 2) gla_prep(p, l, it - 512, lds); }
        else if (mask & 4) diff_prep(p, l, it - 640, lds);
    }
}

DI void lds_barrier() { asm volatile("s_waitcnt lgkmcnt(0)" ::: "memory"); __builtin_amdgcn_s_barrier(); asm volatile("" ::: "memory"); }

struct GlaOps { bf16x8 att[2], vt[2][2], qe[2], kd[2]; f32x4 dec; };
DI void gla_load(const Params& p, size_t ci, int t2, int dh, int sl, int fr, int q4, GlaOps& o) {
    const bf16_t* att = p.gatt + ci * 4096 + (t2 * 16 + fr) * 64 + q4 * 8;
    const bf16_t* qe = p.gqe + ci * 4096 + (t2 * 16 + fr) * 64 + q4 * 8;
    const bf16_t* kdT = p.gkdT + ci * 4096 + (t2 * 16 + fr) * 64 + q4 * 8;
#pragma unroll
    for (int ks = 0; ks < 2; ++ks) { o.att[ks] = *(const bf16x8*)(att + ks * 32); o.qe[ks] = *(const bf16x8*)(qe + ks * 32); o.kd[ks] = *(const bf16x8*)(kdT + ks * 32); }
#pragma unroll
    for (int e = 0; e < 2; ++e) {
        const bf16_t* vT = p.gvT + ci * 8192 + (size_t)(sl * 64 + (2 * dh + e) * 16 + fr) * 64 + q4 * 8;
#pragma unroll
        for (int ks = 0; ks < 2; ++ks) o.vt[e][ks] = *(const bf16x8*)(vT + ks * 32);
    }
    o.dec = *(const f32x4*)(p.gdec + ci * 64 + t2 * 16 + q4 * 4);
}
DI void gla_chain(const Params& p, int id, unsigned char* lds) {
    const int tid = get_tid(), w = tid >> 6, lane = tid & 63, fr = lane & 15, q4 = lane >> 4;
    const int sl = id & 1, bh = id >> 1;
    bf16_t* St = (bf16_t*)lds;
    const int t2 = w >> 1, dh = w & 1;
    const int b = bh >> 2, h = bh & 3;
    f32x4 Sacc[2] = {{0.f, 0.f, 0.f, 0.f}, {0.f, 0.f, 0.f, 0.f}};
    auto step = [&](int n, const GlaOps& cur) {
#pragma unroll
        for (int e = 0; e < 2; ++e) { u32x2 o; o.x = cvt_pk_bf16(Sacc[e][0], Sacc[e][1]); o.y = cvt_pk_bf16(Sacc[e][2], Sacc[e][3]);
          *(u32x2*)(St + ((2 * dh + e) * 16 + fr) * 72 + t2 * 16 + q4 * 4) = o; }
        lds_barrier();
#pragma unroll
        for (int e = 0; e < 2; ++e) {
            f32x4 o = {0.f, 0.f, 0.f, 0.f};
#pragma unroll
            for (int ks = 0; ks < 2; ++ks) o = mfma16(cur.att[ks], cur.vt[e][ks], o);
#pragma unroll
            for (int ks = 0; ks < 2; ++ks) {
                const bf16x8 bs = *(const bf16x8*)(St + ((2 * dh + e) * 16 + fr) * 72 + ks * 32 + q4 * 8);
                o = mfma16(cur.qe[ks], bs, o);
            }
            float* dst = p.ogla + (size_t)(b * SEQ + n * 64 + t2 * 16 + q4 * 4) * 512 + h * 128 + sl * 64 + (2 * dh + e) * 16 + fr;
#pragma unroll
            for (int r = 0; r < 4; ++r) dst[r * 512] = o[r];
            Sacc[e] = Sacc[e] * cur.dec;
#pragma unroll
            for (int ks = 0; ks < 2; ++ks) Sacc[e] = mfma16(cur.kd[ks], cur.vt[e][ks], Sacc[e]);
        }
        lds_barrier();
    };
    GlaOps r0, r1, r2;
    const size_t c0 = (size_t)bh * 32;
    gla_load(p, c0 + 0, t2, dh, sl, fr, q4, r0); gla_load(p, c0 + 1, t2, dh, sl, fr, q4, r1); gla_load(p, c0 + 2, t2, dh, sl, fr, q4, r2);
#pragma unroll 1
    for (int n = 0; n < 33; n += 3) {
        step(n, r0);     gla_load(p, c0 + min(n + 3, 31), t2, dh, sl, fr, q4, r0);
        step(n + 1, r1); gla_load(p, c0 + min(n + 4, 31), t2, dh, sl, fr, q4, r1);
        if (n + 2 < 32) { step(n + 2, r2); gla_load(p, c0 + min(n + 5, 31), t2, dh, sl, fr, q4, r2); }
    }
}

struct GdnOps { bf16x8 am[4], qk[2], kt[2]; float u[4][4]; float cd; };
DI void gdn_load(const Params& p, size_t ci, int w, int ct, int role, int sl, int fr, int q4, GdnOps& o) {
    const bf16_t* am = (role ? p.dqe : p.dw) + ci * 8192 + (ct * 16 + fr) * 128 + q4 * 8;
    const bf16_t* ktT = p.dktT + ci * 8192 + (w * 16 + fr) * 64 + q4 * 8;
#pragma unroll
    for (int ks = 0; ks < 4; ++ks) o.am[ks] = *(const bf16x8*)(am + ks * 32);
#pragma unroll
    for (int ks = 0; ks < 2; ++ks) o.kt[ks] = *(const bf16x8*)(ktT + ks * 32);
    if (role) {
        const bf16_t* qk = p.dqk + ci * 4096 + (ct * 16 + fr) * 64 + q4 * 8;
#pragma unroll
        for (int ks = 0; ks < 2; ++ks) o.qk[ks] = *(const bf16x8*)(qk + ks * 32);
    } else {
#pragma unroll
        for (int e = 0; e < 4; ++e) {
            const float* up = p.du + ci * 8192 + (size_t)(ct * 16 + q4 * 4) * 128 + sl * 64 + e * 16 + fr;
#pragma unroll
            for (int r = 0; r < 4; ++r) o.u[e][r] = up[r * 128];
        }
    }
    o.cd = p.dcd[ci];
}
DI void gdn_chain(const Params& p, int id, unsigned char* lds) {
    const int tid = get_tid(), w = __builtin_amdgcn_readfirstlane(tid >> 6), lane = tid & 63, fr = lane & 15, q4 = lane >> 4;
    const int sl = id & 1, bh = id >> 1;
    bf16_t* St = (bf16_t*)lds;
    bf16_t* VnT = St + 64 * 136;
    const int ct = w >> 1, role = w & 1;
    f32x4 S[4];
#pragma unroll
    for (int i = 0; i < 4; ++i) S[i] = (f32x4){0.f, 0.f, 0.f, 0.f};
    const int b = bh >> 2, h = bh & 3;
    auto step = [&](int n, const GdnOps& cur) {
#pragma unroll
        for (int d = 0; d < 4; ++d) { u32x2 o; o.x = cvt_pk_bf16(S[d][0], S[d][1]); o.y = cvt_pk_bf16(S[d][2], S[d][3]);
          *(u32x2*)(St + (d * 16 + fr) * 136 + w * 16 + q4 * 4) = o; }
        lds_barrier();
        f32x4 acc[4];
#pragma unroll
        for (int e = 0; e < 4; ++e) {
            acc[e] = (f32x4){0.f, 0.f, 0.f, 0.f};
#pragma unroll
            for (int ks = 0; ks < 4; ++ks) {
                const bf16x8 bs = *(const bf16x8*)(St + (e * 16 + fr) * 136 + ks * 32 + q4 * 8);
                acc[e] = mfma16(cur.am[ks], bs, acc[e]);
            }
        }
        if (role == 0) {
#pragma unroll
            for (int e = 0; e < 4; ++e) {
                u32x2 pk; pk.x = cvt_pk_bf16(cur.u[e][0] - acc[e][0], cur.u[e][1] - acc[e][1]); pk.y = cvt_pk_bf16(cur.u[e][2] - acc[e][2], cur.u[e][3] - acc[e][3]);
                *(u32x2*)(VnT + (e * 16 + fr) * 72 + ct * 16 + q4 * 4) = pk;
            }
        }
        lds_barrier();
        if (role == 1) {
#pragma unroll
            for (int e = 0; e < 4; ++e) {
#pragma unroll
                for (int ks = 0; ks < 2; ++ks) { const bf16x8 bo = *(const bf16x8*)(VnT + (e * 16 + fr) * 72 + ks * 32 + q4 * 8); acc[e] = mfma16(cur.qk[ks], bo, acc[e]); }
                float* dst = p.ogdn + (size_t)(b * SEQ + n * 64 + ct * 16 + q4 * 4) * 512 + h * 128 + sl * 64 + e * 16 + fr;
#pragma unroll
                for (int r = 0; r < 4; ++r) dst[r * 512] = acc[e][r];
            }
        }
#pragma unroll
        for (int d = 0; d < 4; ++d) {
            S[d] = S[d] * cur.cd;
#pragma unroll
            for (int ks = 0; ks < 2; ++ks) { const bf16x8 bv = *(const bf16x8*)(VnT + (d * 16 + fr) * 72 + ks * 32 + q4 * 8); S[d] = mfma16(cur.kt[ks], bv, S[d]); }
        }
    };
    GdnOps r0, r1;
    const size_t c0 = (size_t)bh * 32;
    gdn_load(p, c0 + 0, w, ct, role, sl, fr, q4, r0); gdn_load(p, c0 + 1, w, ct, role, sl, fr, q4, r1);
#pragma unroll 1
    for (int n = 0; n < 32; n += 2) {
        step(n, r0);     gdn_load(p, c0 + min(n + 2, 31), w, ct, role, sl, fr, q4, r0);
        step(n + 1, r1); gdn_load(p, c0 + min(n + 3, 31), w, ct, role, sl, fr, q4, r1);
    }
    __syncthreads();
}

DI void attn_item(const Params& p, int l, int item, unsigned char* lds, int ktmul) {
    const int tid = get_tid(), w = __builtin_amdgcn_readfirstlane(tid >> 6), lane = tid & 63, fr = lane & 15, q4 = lane >> 4;
    const int qb = 31 - (item >> 4), bh = item & 15, b = bh >> 2, h = bh & 3;
    const int m = w >> 2, rt = w & 3;
    const int q0 = qb * 64;
    const float lam = p.lam[l];
    LAS unsigned char* L = (LAS unsigned char*)lds;
    const bf16_t* qg = p.qd + ((size_t)((b * 8 + h * 2 + m) * SEQ + q0 + rt * 16 + fr)) * 128;
    bf16x8 qf[4];
#pragma unroll
    for (int ks = 0; ks < 4; ++ks) qf[ks] = *(const bf16x8*)(qg + ks * 32 + q4 * 8);
    const bf16_t* kg = p.kd + ((size_t)(b * 8 + h * 2) * SEQ) * 128;
    const bf16_t* vg = p.vT + ((size_t)(b * 4 + h) * 32) * 16384;
    unsigned koff[4], voff[4];
#pragma unroll
    for (int i = 0; i < 4; ++i) {
        const int gk = w * 4 + i;
        const int rk = gk * 4 + (lane >> 4), ck = (lane & 15) ^ ((rk & 3) | (((rk >> 3) & 3) << 2));
        koff[i] = (unsigned)(((rk >> 6) * SEQ + (rk & 63)) * 128 + ck * 8);
        const int gv = w * 4 + i;
        const int rv = gv * 8 + (lane >> 3), cv = (lane & 7) ^ ((rv >> 1) & 7);
        voff[i] = (unsigned)(rv * 64 + cv * 8);
    }
    auto issue_tile = [&](int kt, int buf) {
#pragma unroll
        for (int i = 0; i < 4; ++i) {
            __builtin_amdgcn_global_load_lds((const unsigned*)(kg + (size_t)kt * 64 * 128 + koff[i]), (LAS unsigned*)(L + buf * 65536 + (w * 4 + i) * 1024), 16, 0, 0);
            __builtin_amdgcn_global_load_lds((const unsigned*)(vg + (size_t)kt * 16384 + voff[i]), (LAS unsigned*)(L + buf * 65536 + 32768 + (w * 4 + i) * 1024), 16, 0, 0);
        }
    };
    f32x4 O[16];
#pragma unroll
    for (int i = 0; i < 16; ++i) O[i] = (f32x4){0.f, 0.f, 0.f, 0.f};
    float mrun = 0.f, lrun = 0.f;
    const int qglob = q0 + rt * 16 + fr;
    const int krow = (fr >> 2) * 8 + (fr & 3);
    const unsigned kro = (unsigned)((m * 64 + krow) * 256);
    const unsigned vro = (unsigned)(fr * 128);
    const int vsw = (fr >> 1) & 7;
    issue_tile(0, 0);
    for (int kt = 0; kt <= qb; ++kt) {
        asm volatile("s_waitcnt vmcnt(0)" ::: "memory");
        __syncthreads();
        const int buf = kt & 1;
        if (kt < qb) issue_tile((kt + 1) * ktmul, buf ^ 1);
        const LAS unsigned char* Kb = L + buf * 65536 + kro;
        const LAS unsigned char* Vb = L + buf * 65536 + 32768 + vro;
        f32x4 sc[4];
        const float negm = -mrun;
#pragma unroll
        for (int j = 0; j < 4; ++j) {
            sc[j] = (f32x4){negm, negm, negm, negm};
#pragma unroll
            for (int ks = 0; ks < 4; ++ks) {
                const bf16x8 a = *(const LAS bf16x8*)(Kb + ((j >> 1) * 32 + (j & 1) * 4) * 256 + (((ks * 4 + q4) ^ fr) << 4));
                sc[j] = mfma16(a, qf[ks], sc[j]);
            }
        }
        if (kt == qb) {
#pragma unroll
            for (int j = 0; j < 4; ++j)
#pragma unroll
                for (int r = 0; r < 4; ++r) if (kt * 64 + (j >> 1) * 32 + q4 * 8 + (j & 1) * 4 + r > qglob) sc[j][r] = -1e30f;
        }
        float tm = -1e30f;
#pragma unroll
        for (int j = 0; j < 4; ++j)
#pragma unroll
            for (int r = 0; r < 4; ++r) tm = fmaxf(tm, sc[j][r]);
        tm = xch16_max(tm); tm = xch32_max(tm);
        if (__builtin_amdgcn_ballot_w64(tm > 6.0f) != 0ull) {
            const float d = fmaxf(tm, 0.f);
            const float alpha = __builtin_amdgcn_exp2f(-d);
            mrun += d;
            lrun *= alpha;
#pragma unroll
            for (int i = 0; i < 16; ++i) O[i] = O[i] * alpha;
#pragma unroll
            for (int j = 0; j < 4; ++j)
#pragma unroll
                for (int r = 0; r < 4; ++r) sc[j][r] -= d;
        }
        float ps = 0.f;
#pragma unroll
        for (int j = 0; j < 4; ++j)
#pragma unroll
            for (int r = 0; r < 4; ++r) { const float pv = __builtin_amdgcn_exp2f(sc[j][r]); sc[j][r] = pv; ps += pv; }
        lrun += ps;
        bf16x8 pf[2];
#pragma unroll
        for (int k2 = 0; k2 < 2; ++k2) {
            u32x4 t; t.x = cvt_pk_bf16(sc[2 * k2][0], sc[2 * k2][1]); t.y = cvt_pk_bf16(sc[2 * k2][2], sc[2 * k2][3]);
            t.z = cvt_pk_bf16(sc[2 * k2 + 1][0], sc[2 * k2 + 1][1]); t.w = cvt_pk_bf16(sc[2 * k2 + 1][2], sc[2 * k2 + 1][3]);
            pf[k2] = as_bf16x8(t);
        }
#pragma unroll
        for (int dvt = 0; dvt < 16; ++dvt)
#pragma unroll
            for (int k2 = 0; k2 < 2; ++k2) {
                const bf16x8 av = *(const LAS bf16x8*)(Vb + dvt * 2048 + (((4 * k2 + q4) ^ vsw) << 4));
                O[dvt] = mfma16(av, pf[k2], O[dvt]);
            }
    }
    lrun = xch16_add(lrun); lrun = xch32_add(lrun);
    const float fac = (m == 0 ? 1.f : lam) / lrun;
    __syncthreads();
    float* Ox = (float*)lds;
    if (m == 1) {
#pragma unroll
        for (int dvt = 0; dvt < 16; ++dvt) *(f32x4*)(Ox + (rt * 16 + fr) * 260 + dvt * 16 + q4 * 4) = O[dvt] * fac;
    }
    __syncthreads();
    if (m == 0) {
        float ss = 0.f;
#pragma unroll
        for (int dvt = 0; dvt < 16; ++dvt) {
            const f32x4 o2 = *(const f32x4*)(Ox + (rt * 16 + fr) * 260 + dvt * 16 + q4 * 4);
            O[dvt] = O[dvt] * fac - o2;
            ss += O[dvt][0] * O[dvt][0] + O[dvt][1] * O[dvt][1] + O[dvt][2] * O[dvt][2] + O[dvt][3] * O[dvt][3];
        }
        ss = xch16_add(ss); ss = xch32_add(ss);
        const float lam_init = 0.8f - 0.6f * expf(-0.3f * (float)l);
        const float rstd = rsqrtf(ss * (1.f / 256.f) + 1e-6f) * (1.f - lam_init);
        const size_t t = (size_t)b * SEQ + qglob;
        u32x2 zr16[16]; f32x4 nw16[16];
#pragma unroll
        for (int dvt = 0; dvt < 16; ++dvt) {
            zr16[dvt] = *(const u32x2*)(p.proj + t * NPROJ + 6656 + h * 256 + dvt * 16 + q4 * 4);
            nw16[dvt] = *(const f32x4*)(p.diff_norm_w + l * 256 + dvt * 16 + q4 * 4);
        }
#pragma unroll
        for (int dvt = 0; dvt < 16; ++dvt) {
            const int dv = dvt * 16 + q4 * 4;
            const f32x4 nw = nw16[dvt];
            const u32x2 zr = zr16[dvt];
            const float z0 = bf_lo(zr.x), z1 = bf_hi(zr.x), z2 = bf_lo(zr.y), z3 = bf_hi(zr.y);
            u32x2 ov;
            ov.x = cvt_pk_bf16(O[dvt][0] * rstd * nw[0] * siluf(z0), O[dvt][1] * rstd * nw[1] * siluf(z1));
            ov.y = cvt_pk_bf16(O[dvt][2] * rstd * nw[2] * siluf(z2), O[dvt][3] * rstd * nw[3] * siluf(z3));
            *(u32x2*)(p.concat + t * DM + 1024 + h * 256 + dv) = ov;
        }
    }
    __syncthreads();
}

DI void phase4(const Params& p, int lc, unsigned char* lds) {
    const int l = lc & 1;
    const int bid = get_bid();
    if (!((PROBE_PHASE == 42 || PROBE_PHASE == 43) && lc >= 2)) {
    const int cw = bid & 15, cid = ((((bid >> 4) & 1) * 8 + (cw & 7)) << 1) | (cw >> 3);
    if (bid < 32) gdn_chain(p, cid, lds);
    else if (bid < 64) gla_chain(p, cid, lds);
    }
    if (PROBE_PHASE == 41 && lc >= 2) return;
    unsigned* slot = (unsigned*)(lds + LDS_BYTES - 16);
    const int xcd = bid & 7;
    for (;;) {
        __syncthreads();
        if (get_tid() == 0) *slot = atomicAdd(p.cnt + lc * 8 + xcd, 1u);
        __syncthreads();
        const unsigned idx = *slot;
        if (idx >= 64u) break;
        attn_item(p, l, (int)(((idx >> 1) << 4) | (2 * xcd + (idx & 1))), lds, (PROBE_PHASE == 43 && lc >= 2) ? 0 : 1);
    }
}

DI void phase5(const Params& p, int l) {
    const int tid = get_tid();
    const int i16 = tid & 15;
    const int gidx = get_bid() * 32 + (tid >> 4), gstride = gridDim.x * 32;
    const f32x4 nwa0 = *(const f32x4*)(p.gla_norm_w + l * 128 + i16 * 8), nwa1 = *(const f32x4*)(p.gla_norm_w + l * 128 + i16 * 8 + 4);
    const f32x4 nwd0 = *(const f32x4*)(p.gdn_norm_w + l * 128 + i16 * 8), nwd1 = *(const f32x4*)(p.gdn_norm_w + l * 128 + i16 * 8 + 4);
    for (int it0 = gidx; it0 < TT * 8; it0 += 4 * gstride) {
        f32x4 v0[4], v1[4]; u32x4 zr[4];
#pragma unroll
        for (int u = 0; u < 4; ++u) {
            int it = it0 + u * gstride; if (it >= TT * 8) it = it0; const int t = it >> 3, g = (it >> 2) & 1, h = it & 3;
            const float* src = (g ? p.ogdn : p.ogla) + (size_t)t * 512 + h * 128 + i16 * 8;
            v0[u] = *(const f32x4*)src; v1[u] = *(const f32x4*)(src + 4);
            zr[u] = *(const u32x4*)(p.proj + (size_t)t * NPROJ + (g ? 3072 : 1024) + h * 128 + i16 * 8);
        }
#pragma unroll
        for (int u = 0; u < 4; ++u) {
            const int it = it0 + u * gstride; if (it >= TT * 8) break; const int t = it >> 3, g = (it >> 2) & 1, h = it & 3;
            float ss = v0[u][0] * v0[u][0] + v0[u][1] * v0[u][1] + v0[u][2] * v0[u][2] + v0[u][3] * v0[u][3]
                     + v1[u][0] * v1[u][0] + v1[u][1] * v1[u][1] + v1[u][2] * v1[u][2] + v1[u][3] * v1[u][3];
            ss = sum16(ss);
            const float rstd = rsqrtf(ss * (1.f / 128.f) + 1e-6f);
            const f32x4 n0 = g ? nwd0 : nwa0, n1 = g ? nwd1 : nwa1;
            u32x4 o;
            o.x = cvt_pk_bf16(v0[u][0] * rstd * n0[0] * siluf(bf_lo(zr[u].x)), v0[u][1] * rstd * n0[1] * siluf(bf_hi(zr[u].x)));
            o.y = cvt_pk_bf16(v0[u][2] * rstd * n0[2] * siluf(bf_lo(zr[u].y)), v0[u][3] * rstd * n0[3] * siluf(bf_hi(zr[u].y)));
            o.z = cvt_pk_bf16(v1[u][0] * rstd * n1[0] * siluf(bf_lo(zr[u].z)), v1[u][1] * rstd * n1[1] * siluf(bf_hi(zr[u].z)));
            o.w = cvt_pk_bf16(v1[u][2] * rstd * n1[2] * siluf(bf_lo(zr[u].w)), v1[u][3] * rstd * n1[3] * siluf(bf_hi(zr[u].w)));
            *(u32x4*)(p.concat + (size_t)t * DM + g * 512 + h * 128 + i16 * 8) = o;
        }
    }
}

#define XB_TMO      128
#define XB_XCNT(j)  (256  + 64 * (j))
#define XB_XSUB(j)  (1280 + 64 * (j))
#define XB_XGEN(j)  (2304 + 64 * (j))
#define XB_TOP      3328
#define XB_TOPGEN   3392
#define XCD_BAR_WORDS 3456
#define XB_SPIN_CAP (1u << 18)
DI unsigned xb_ld(unsigned* q)              { return __hip_atomic_load(q, __ATOMIC_RELAXED, __HIP_MEMORY_SCOPE_AGENT); }
DI unsigned xb_add(unsigned* q, unsigned v) { return __hip_atomic_fetch_add(q, v, __ATOMIC_RELAXED, __HIP_MEMORY_SCOPE_AGENT); }
DI unsigned xb_xcc_id() { return (unsigned)__builtin_amdgcn_s_getreg((3 << 11) | 20) & 0xFu; }
#define XB_SPIN(cond, bar) do { unsigned _sp = 0; while (cond) { __builtin_amdgcn_s_sleep(1); \
    if ((++_sp & 255u) == 0u) { if (xb_ld(&(bar)[XB_TMO])) break; if (_sp > XB_SPIN_CAP) { atomicAdd(&(bar)[XB_TMO], 1u); break; } } } } while (0)
struct XcdBarrier { unsigned* bar; unsigned x; volatile LAS unsigned* st; };
DI XcdBarrier xcd_barrier_post(unsigned* bar, volatile LAS unsigned* st) {
    XcdBarrier b; b.bar = bar; b.x = xb_xcc_id(); b.st = st;
    if (threadIdx.x == 0) (void)xb_add(&bar[XB_XCNT(b.x)], 1u);
    return b;
}
DI void xcd_barrier_complete(unsigned* bar, unsigned x, unsigned& nloc, unsigned& nx) {
    const unsigned G = gridDim.x * gridDim.y * gridDim.z;
    unsigned sum, cnt, mine, sp = 0u;
    for (;;) {
        sum = 0u; cnt = 0u; mine = 0u;
#pragma unroll
        for (unsigned j = 0; j < 16; ++j) { const unsigned c = xb_ld(&bar[XB_XCNT(j)]); sum += c; cnt += (c > 0u) ? 1u : 0u; mine = (j == x) ? c : mine; }
        if (sum == G) break;
        __builtin_amdgcn_s_sleep(1);
        if ((++sp & 255u) == 0u) { if (xb_ld(&bar[XB_TMO])) break; if (sp > XB_SPIN_CAP) { atomicAdd(&bar[XB_TMO], 1u); break; } }
    }
    nloc = mine > 0u ? mine : 1u; nx = cnt > 0u ? cnt : 1u;
}
DI void xcd_barrier(const XcdBarrier& b) {
    asm volatile("s_waitcnt vmcnt(0)" ::: "memory");
    __syncthreads();
    if (threadIdx.x == 0) {
        unsigned* bar = b.bar;
        __builtin_amdgcn_s_waitcnt(0);
        unsigned nloc = b.st[0], nx = b.st[1];
        if (nloc == 0u) { xcd_barrier_complete(bar, b.x, nloc, nx); b.st[0] = nloc; b.st[1] = nx; }
        const unsigned old = xb_add(&bar[XB_XSUB(b.x)], 1u);
        const unsigned gen = old / nloc;
        if (old + 1u == (gen + 1u) * nloc) {
            __builtin_amdgcn_fence(__ATOMIC_RELEASE, "agent");
            asm volatile("s_waitcnt vmcnt(0)" ::: "memory");
            const unsigned og = xb_add(&bar[XB_TOP], 1u);
            const unsigned tg = og / nx;
            if (og + 1u == (tg + 1u) * nx) xb_add(&bar[XB_TOPGEN], 1u);
            else XB_SPIN(xb_ld(&bar[XB_TOPGEN]) == tg, bar);
            __builtin_amdgcn_fence(__ATOMIC_ACQUIRE, "agent");
            xb_add(&bar[XB_XGEN(b.x)], 1u);
            asm volatile("s_waitcnt vmcnt(0)" ::: "memory");
        } else {
            XB_SPIN(xb_ld(&bar[XB_XGEN(b.x)]) == gen, bar);
            __builtin_amdgcn_fence(__ATOMIC_ACQUIRE, "agent");
            asm volatile("s_waitcnt vmcnt(0)" ::: "memory");
        }
    }
    __syncthreads();
}

__global__ void __launch_bounds__(512, 2) fwd_megakernel(Params p_unused) {
    extern __shared__ __attribute__((aligned(16))) unsigned char shm[];
    cg::grid_group grid = cg::this_grid();
    volatile LAS unsigned* xst = (volatile LAS unsigned*)((LAS unsigned char*)shm + (LDS_BYTES - 32));
    if (threadIdx.x < 2) xst[threadIdx.x] = 0u;
    __syncthreads();
    XcdBarrier xb;
    { const Params p = load_params(); xb = xcd_barrier_post(p.bar, xst); }
    { const Params p = load_params(); phase0(p, (float*)shm); }
    grid.sync();
#if PROBE_PHASE == 10
    { const Params p = load_params(); phase0(p, (float*)shm); }
    xcd_barrier(xb);
#endif
#pragma unroll 1
    for (int l = 0; l < 2; ++l) {
#pragma unroll 1
        for (int rep = 0; rep < (PROBE_PHASE == 1 ? 2 : 1); ++rep) {
        { const Params p = load_params(); phase1(p, l, l == 0 ? p.x : p.x1); }
        xcd_barrier(xb);
        }
#pragma unroll 1
        for (int rep = 0; rep < (PROBE_PHASE == 2 ? 2 : 1); ++rep) {
            const Params p = load_params();
            pg8::StaticOrder S; S.init(TT, NPAD, (int)gridDim.x, get_bid());
            pg8::Gemm g{p.hbuf, p.WinT + (size_t)l * NPAD * 2048, TT, NPAD, 2048};
            EpiProj E{p.proj, p.small};
            pg8::gemm_phase<EpiProj>((LAS unsigned char*)shm, g, S, E);
            xcd_barrier(xb);
        }
#pragma unroll 1
        for (int rep = 0; rep < ((PROBE_PHASE == 3 || (PROBE_PHASE >= 31 && PROBE_PHASE <= 36)) ? 2 : 1); ++rep) {
        { const Params p = load_params(); phase3(p, l, shm, (rep == 0 || PROBE_PHASE == 3) ? 7 : (PROBE_PHASE == 32 ? 2 : (PROBE_PHASE == 33 ? 4 : 1)), (rep == 1 && PROBE_PHASE >= 34) ? PROBE_PHASE - 33 : 0); }
        xcd_barrier(xb);
        }
#pragma unroll 1
        for (int rep = 0; rep < ((PROBE_PHASE == 4 || PROBE_PHASE == 41 || PROBE_PHASE == 42 || PROBE_PHASE == 43) ? 2 : 1); ++rep) {
        { Params p = load_params(); if (PROBE_PHASE == 43 && rep == 1) p.concat = p.hbuf; phase4(p, l + 2 * rep, shm); }
        xcd_barrier(xb);
        }
#pragma unroll 1
        for (int rep = 0; rep < (PROBE_PHASE == 5 ? 2 : 1); ++rep) {
        { const Params p = load_params(); phase5(p, l); }
        xcd_barrier(xb);
        }
#pragma unroll 1
        for (int rep = 0; rep < (PROBE_PHASE == 6 ? 2 : 1); ++rep) {
            const Params p = load_params();
            pg8::StaticOrder S; S.init(TT, DM, (int)gridDim.x, get_bid());
            pg8::Gemm g{p.concat, p.WoutT + (size_t)l * 2048 * 2048, TT, DM, 2048};
            EpiOut E{l == 0 ? p.x : p.x1, l == 0 ? p.x1 : p.out, p.mod + (size_t)l * 4 * 6144 + 4096};
            pg8::gemm_phase<EpiOut>((LAS unsigned char*)shm, g, S, E);
            xcd_barrier(xb);
        }
    }
}

#ifdef MULTI_LAUNCH
__global__ void __launch_bounds__(512, 2) k_p0(Params p) { extern __shared__ __attribute__((aligned(16))) unsigned char shm[]; phase0(p, (float*)shm); }
__global__ void __launch_bounds__(512, 2) k_p1(Params p, int l) { phase1(p, l, l == 0 ? p.x : p.x1); }
__global__ void __launch_bounds__(512, 2) k_p2(Params p, int l) { extern __shared__ __attribute__((aligned(16))) unsigned char shm[];
    pg8::StaticOrder S; S.init(TT, NPAD, (int)gridDim.x, (int)blockIdx.x);
    pg8::Gemm g{p.hbuf, p.WinT + (size_t)l * NPAD * 2048, TT, NPAD, 2048};
    EpiProj E{p.proj, p.small};
    pg8::gemm_phase<EpiProj>((LAS unsigned char*)shm, g, S, E); }
__global__ void __launch_bounds__(512, 2) k_p3a(Params p, int l) { extern __shared__ __attribute__((aligned(16))) unsigned char shm[]; for (int it = blockIdx.x; it < 512; it += gridDim.x) gdn_prep(p, l, it, shm); }
__global__ void __launch_bounds__(512, 2) k_p3b(Params p, int l) { extern __shared__ __attribute__((aligned(16))) unsigned char shm[]; for (int it = blockIdx.x; it < 128; it += gridDim.x) gla_prep(p, l, it, shm); }
__global__ void __launch_bounds__(512, 2) k_p3c(Params p, int l) { extern __shared__ __attribute__((aligned(16))) unsigned char shm[]; for (int it = blockIdx.x; it < 128; it += gridDim.x) diff_prep(p, l, it, shm); }
__global__ void __launch_bounds__(512, 2) k_p4a(Params p, int l) { extern __shared__ __attribute__((aligned(16))) unsigned char shm[]; gdn_chain(p, blockIdx.x, shm); }
__global__ void __launch_bounds__(512, 2) k_p4b(Params p, int l) { extern __shared__ __attribute__((aligned(16))) unsigned char shm[]; gla_chain(p, blockIdx.x, shm); }
__global__ void __launch_bounds__(512, 2) k_p4c(Params p, int l) { extern __shared__ __attribute__((aligned(16))) unsigned char shm[]; attn_item(p, l, blockIdx.x, shm); }
__global__ void __launch_bounds__(512, 2) k_p5(Params p, int l) { phase5(p, l); }
__global__ void __launch_bounds__(512, 2) k_p6(Params p, int l) { extern __shared__ __attribute__((aligned(16))) unsigned char shm[];
    pg8::StaticOrder S; S.init(TT, DM, (int)gridDim.x, (int)blockIdx.x);
    pg8::Gemm g{p.concat, p.WoutT + (size_t)l * 2048 * 2048, TT, DM, 2048};
    EpiOut E{l == 0 ? p.x : p.x1, l == 0 ? p.x1 : p.out, p.mod + (size_t)l * 4 * 6144 + 4096};
    pg8::gemm_phase<EpiOut>((LAS unsigned char*)shm, g, S, E); }
#endif

extern "C" void kernel_launch(void* const* d_in, const int* in_sizes, int n_in, void* d_out, int out_size, void* d_ws, size_t ws_size, hipStream_t stream) {
    static int grid_blocks = 0;
    if (!grid_blocks) {
        int dev = 0, cus = 0, per_cu = 0;
        hipGetDevice(&dev);
        hipDeviceGetAttribute(&cus, hipDeviceAttributeMultiprocessorCount, dev);
        hipFuncSetAttribute((const void*)fwd_megakernel, hipFuncAttributeMaxDynamicSharedMemorySize, LDS_BYTES);
        hipOccupancyMaxActiveBlocksPerMultiprocessor(&per_cu, fwd_megakernel, 512, LDS_BYTES);
        if (per_cu < 1) per_cu = 1;
        if (per_cu > 1) per_cu = 1;
        grid_blocks = cus * per_cu;
    }
    Params p{};
    p.x = (const float*)d_in[0]; p.c = (const float*)d_in[1]; p.pos = (const int*)d_in[2];
    p.norm_w = (const float*)d_in[3]; p.w_ada = (const float*)d_in[4]; p.b_ada = (const float*)d_in[5]; p.w_in = (const float*)d_in[6];
    p.gla_w_lr = (const float*)d_in[7]; p.gla_b_lr = (const float*)d_in[8]; p.gla_norm_w = (const float*)d_in[9];
    p.gdn_conv_w = (const float*)d_in[10]; p.gdn_a_log = (const float*)d_in[11]; p.gdn_dt_bias = (const float*)d_in[12]; p.gdn_norm_w = (const float*)d_in[13];
    p.diff_q_norm_w = (const float*)d_in[14]; p.diff_k_norm_w = (const float*)d_in[15]; p.diff_lambda = (const float*)d_in[16]; p.diff_norm_w = (const float*)d_in[17];
    p.w_out = (const float*)d_in[18];
    p.out = (float*)d_out;
    char* ws = (char*)d_ws; size_t off = 0;
    auto take = [&](size_t bytes) { char* r = ws + off; off += (bytes + 255) & ~(size_t)255; return r; };
    p.WinT = (bf16_t*)take((size_t)2 * NPAD * 2048 * 2);
    p.WoutT = (bf16_t*)take((size_t)2 * 2048 * 2048 * 2);
    p.mod = (float*)take((size_t)2 * 4 * 6144 * 4);
    p.rope = (float*)take((size_t)TT * 128 * 4);
    p.lam = (float*)take(256);
    p.cnt = (unsigned*)take(256);
    p.bar = (unsigned*)take((size_t)XCD_BAR_WORDS * 4);
    p.hbuf = (bf16_t*)take((size_t)TT * DM * 2);
    p.proj = (bf16_t*)take((size_t)TT * NPROJ * 2);
    p.small = (float*)take((size_t)TT * 32 * 4);
    p.x1 = (float*)d_out;
    p.concat = (bf16_t*)take((size_t)TT * DM * 2);
    p.gqe = (bf16_t*)take((size_t)512 * 4096 * 2);
    p.gatt = (bf16_t*)take((size_t)512 * 4096 * 2);
    p.gkdT = (bf16_t*)take((size_t)512 * 4096 * 2);
    p.gvT = (bf16_t*)take((size_t)512 * 8192 * 2);
    p.gdec = (float*)take((size_t)512 * 64 * 4);
    p.ogla = (float*)p.hbuf;
    p.du = (float*)take((size_t)512 * 8192 * 4);
    p.dw = (bf16_t*)take((size_t)512 * 8192 * 2);
    p.dqe = (bf16_t*)take((size_t)512 * 8192 * 2);
    p.dktT = (bf16_t*)take((size_t)512 * 8192 * 2);
    p.dqk = (bf16_t*)take((size_t)512 * 4096 * 2);
    p.dcd = (float*)take((size_t)512 * 4);
    p.ogdn = (float*)p.hbuf + (size_t)TT * 512;
    p.qd = (bf16_t*)take((size_t)32 * SEQ * 128 * 2);
    p.kd = (bf16_t*)take((size_t)32 * SEQ * 128 * 2);
    p.vT = (bf16_t*)take((size_t)16 * 256 * SEQ * 2);
    if (off > ws_size) { fprintf(stderr, "workspace too small: need %zu have %zu\n", off, ws_size); return; }
    (void)hipMemsetAsync(p.bar, 0, (size_t)XCD_BAR_WORDS * 4, stream);
    void* args[] = {&p};
    hipError_t e = hipLaunchCooperativeKernel((void*)fwd_megakernel, dim3(grid_blocks), dim3(512), args, LDS_BYTES, stream);
    if (e != hipSuccess) fprintf(stderr, "cooperative launch failed: %s (grid %d)\n", hipGetErrorString(e), grid_blocks);
}
```
